# Optimizing an MI355X kernel written in HIP

```python
import math
import jax
import jax.numpy as jnp
from jax import lax
import numpy as np

D_MODEL = 2048
BATCH = 2
SEQ = 4096
DEPTH = 2

CTX_LEN = 256
GRID_W = 64
HEAD_DIM = 128
CHUNK = 64
GLA_HEADS = 4
GLA_DK = 64
GLA_DV = 128
GLA_RANK = 16
GLA_GATE_NORM = 16.0
GDN_HEADS = 4
GDN_DK = 128
GDN_DV = 128
GDN_CONV = 5
GDN_CONV_CH = 2 * GDN_HEADS * GDN_DK + GDN_HEADS * GDN_DV
ATTN_HEADS = 8
ATTN_KV_HEADS = 2
ATTN_GROUP = ATTN_HEADS // ATTN_KV_HEADS
ROPE_THETA = 10000.0
Q_BLOCK = 128
N_EXPERTS = 16
EC_FACTOR = 2
EXPERT_FF = 2048
N_MOD = 6
DEEPNORM_ALPHA = (2 * DEPTH) ** 0.25
DEEPNORM_BETA = (8 * DEPTH) ** -0.25
MIX_WIDTH = GLA_HEADS * GLA_DV + GDN_HEADS * GDN_DV + ATTN_HEADS * HEAD_DIM
IN_SPLITS = (
    GLA_HEADS * GLA_DK, GLA_HEADS * GLA_DK, GLA_HEADS * GLA_DV, GLA_HEADS * GLA_DV, 2 * GLA_RANK,
    GDN_HEADS * GDN_DK, GDN_HEADS * GDN_DK, GDN_HEADS * GDN_DV, GDN_HEADS * GDN_DV, 2 * GDN_HEADS, 2 * GDN_HEADS,
    ATTN_HEADS * HEAD_DIM, ATTN_KV_HEADS * HEAD_DIM, ATTN_KV_HEADS * HEAD_DIM,
)
IN_WIDTH = sum(IN_SPLITS)

kernel_name = 'hybrid_gla_gdn_gqa_ec_moe_diffusion_block'


def _layer_norm(x, gain, bias, eps=1e-5):
    xf = x.astype(jnp.float32)
    mu = jnp.mean(xf, axis=-1, keepdims=True)
    var = jnp.mean(jnp.square(xf - mu), axis=-1, keepdims=True)
    return ((xf - mu) * lax.rsqrt(var + eps) * gain + bias).astype(x.dtype)


def _rms_norm(x, gain, eps=1e-6):
    xf = x.astype(jnp.float32)
    return xf * lax.rsqrt(jnp.mean(xf * xf, axis=-1, keepdims=True) + eps) * gain


def _l2norm(x, eps=1e-6):
    return x * lax.rsqrt(jnp.sum(x * x, axis=-1, keepdims=True) + eps)


def _modulate(x, shift, scale):
    return x * (1.0 + scale) + shift


def _split_cols(p):
    points = np.cumsum(np.array(IN_SPLITS))[:-1].tolist()
    return jnp.split(p, points, axis=-1)


def _heads(a, n_heads):
    b, t, _ = a.shape
    return a.reshape(b, t, n_heads, -1).transpose(0, 2, 1, 3)


def _depthwise_conv(x, w):
    k = w.shape[0]
    return lax.conv_general_dilated(
        x, w.astype(x.dtype)[:, None, :], window_strides=(1,), padding=[(k // 2, k // 2)],
        dimension_numbers=('NWC', 'WIO', 'NWC'), feature_group_count=x.shape[-1])


def _axial_rope_tables(n_tokens):
    rows = n_tokens // GRID_W
    row = jnp.broadcast_to(jnp.arange(rows)[:, None], (rows, GRID_W)).reshape(-1).astype(jnp.float32)
    col = jnp.broadcast_to(jnp.arange(GRID_W)[None, :], (rows, GRID_W)).reshape(-1).astype(jnp.float32)
    half = HEAD_DIM // 2
    inv = ROPE_THETA ** (-jnp.arange(0, half, 2, dtype=jnp.float32) / half)
    ang = jnp.concatenate([row[:, None] * inv, col[:, None] * inv], axis=-1)
    return jnp.cos(ang), jnp.sin(ang)


def _apply_axial_rope(x, cos, sin):
    n = x.shape[1]
    quarter = HEAD_DIM // 4
    bshape = (1, n) + (1,) * (x.ndim - 3) + (2, quarter)
    c = cos.reshape(bshape)
    s = sin.reshape(bshape)
    xr = x.reshape(x.shape[:-1] + (2, 2, quarter))
    x1 = xr[..., 0, :]
    x2 = xr[..., 1, :]
    return jnp.stack([x1 * c - x2 * s, x2 * c + x1 * s], axis=-2).reshape(x.shape)


def _gla_chunked(q, k, v, log_a, s0, with_out):
    b_, h_, t_, dk = q.shape
    dv = v.shape[-1]
    n = t_ // CHUNK
    q = q.reshape(b_, h_, n, CHUNK, dk)
    k = k.reshape(b_, h_, n, CHUNK, dk)
    v = v.reshape(b_, h_, n, CHUNK, dv)
    cum = jnp.cumsum(log_a.reshape(b_, h_, n, CHUNK, dk), axis=3)
    cum_last = cum[:, :, :, -1]
    kv = jnp.einsum('bhnck,bhncv->bhnkv', k * jnp.exp(cum_last[:, :, :, None] - cum), v)
    d_last = jnp.exp(cum_last)
    seq = lambda a: jnp.moveaxis(a, 2, 0)
    if with_out:
        q_dec = q * jnp.exp(cum)
        lower = jnp.tril(jnp.ones((CHUNK, CHUNK), dtype=bool))
        a_intra = jnp.where(lower, jnp.einsum('bhnik,bhnjk->bhnij', q_dec, k * jnp.exp(-cum)), 0.0)
        o_intra = jnp.einsum('bhnij,bhnjv->bhniv', a_intra, v)
        xs = (seq(kv), seq(d_last), seq(q_dec))
    else:
        xs = (seq(kv), seq(d_last))

    def step(state, inp):
        nxt = inp[1][..., None] * state + inp[0]
        if not with_out:
            return nxt, None
        return nxt, jnp.einsum('bhck,bhkv->bhcv', inp[2], state)

    state, o_inter = lax.scan(step, s0, xs)
    if not with_out:
        return None, state
    o = o_intra + jnp.moveaxis(o_inter, 0, 2)
    return o.reshape(b_, h_, t_, dv), state


def _gdn_chunked(q, k, v, g, beta, s0, with_out):
    b_, h_, t_, dk = q.shape
    dv = v.shape[-1]
    n = t_ // CHUNK
    q = q.reshape(b_, h_, n, CHUNK, dk)
    k = k.reshape(b_, h_, n, CHUNK, dk)
    v = v.reshape(b_, h_, n, CHUNK, dv)
    g = jnp.cumsum(g.reshape(b_, h_, n, CHUNK), axis=-1)
    beta = beta.reshape(b_, h_, n, CHUNK)
    k_beta = k * beta[..., None]
    v_beta = v * beta[..., None]
    lower = jnp.tril(jnp.ones((CHUNK, CHUNK), dtype=bool))
    strict = jnp.tril(jnp.ones((CHUNK, CHUNK), dtype=bool), -1)
    gamma = jnp.where(lower, jnp.exp(jnp.where(lower, g[..., :, None] - g[..., None, :], 0.0)), 0.0)
    l_mat = jnp.where(strict, jnp.einsum('bhnid,bhnjd->bhnij', k_beta, k) * gamma, 0.0)
    eye = jnp.eye(CHUNK, dtype=l_mat.dtype)
    t_mat = lax.linalg.triangular_solve(l_mat + eye, jnp.broadcast_to(eye, l_mat.shape),
                                        left_side=True, lower=True, unit_diagonal=True)
    u = jnp.einsum('bhnij,bhnjv->bhniv', t_mat, v_beta)
    w = jnp.einsum('bhnij,bhnjk->bhnik', t_mat, k_beta * jnp.exp(g)[..., None])
    g_last = g[..., -1]
    k_dec = k * jnp.exp(g_last[..., None] - g)[..., None]
    d_last = jnp.exp(g_last)
    seq = lambda a: jnp.moveaxis(a, 2, 0)
    if with_out:
        q_dec = q * jnp.exp(g)[..., None]
        a_intra = jnp.where(lower, jnp.einsum('bhnik,bhnjk->bhnij', q, k) * gamma, 0.0)
        xs = tuple(seq(a) for a in (u, w, k_dec, d_last, q_dec, a_intra))
    else:
        xs = tuple(seq(a) for a in (u, w, k_dec, d_last))

    def step(state, inp):
        u_c, w_c, k_c, d_c = inp[:4]
        v_new = u_c - jnp.einsum('bhck,bhkv->bhcv', w_c, state)
        nxt = d_c[..., None, None] * state + jnp.einsum('bhck,bhcv->bhkv', k_c, v_new)
        if not with_out:
            return nxt, None
        q_c, a_c = inp[4:]
        o = jnp.einsum('bhck,bhkv->bhcv', q_c, state) + jnp.einsum('bhij,bhjv->bhiv', a_c, v_new)
        return nxt, o

    state, o = lax.scan(step, s0, xs)
    if not with_out:
        return None, state
    return jnp.moveaxis(o, 0, 2).reshape(b_, h_, t_, dv), state


def _bidirectional(chunk_fn, ctx_in, lat_in, s0, with_ctx_out):
    o_ctx, o_lat = None, None
    for direction in range(2):
        tf = (lambda a: a) if direction == 0 else (lambda a: jnp.flip(a, axis=2))
        oc, s_ctx = chunk_fn(*[tf(a) for a in ctx_in[direction]], s0, with_ctx_out)
        ol, _ = chunk_fn(*[tf(a) for a in lat_in[direction]], s_ctx, True)
        ol = tf(ol)
        o_lat = ol if o_lat is None else o_lat + ol
        if with_ctx_out:
            oc = tf(oc)
            o_ctx = oc if o_ctx is None else o_ctx + oc
    return o_ctx, o_lat


def _gla_mixer(parts_ctx, parts_lat, w_up, b_up, norm_gain, with_ctx_out):
    def prep(parts):
        q, k, v, g, r = parts
        b_, t_, _ = q.shape
        q = _heads(q, GLA_HEADS).astype(jnp.float32) * GLA_DK ** -0.5
        k = _heads(k, GLA_HEADS).astype(jnp.float32)
        v = _heads(v, GLA_HEADS).astype(jnp.float32)
        r = r.reshape(b_, t_, 2, GLA_RANK)
        logit = jnp.einsum('btzr,zrk->zbtk', r, w_up) + b_up[:, None, None, :]
        log_a = jax.nn.log_sigmoid(logit.astype(jnp.float32)) / GLA_GATE_NORM
        log_a = log_a.reshape(2, b_, t_, GLA_HEADS, GLA_DK).transpose(0, 1, 3, 2, 4)
        return [(q, k, v, log_a[0]), (q, k, v, log_a[1])], g

    def finish(o, g):
        b_, _, t_, _ = o.shape
        o = _rms_norm(o.transpose(0, 2, 1, 3), norm_gain).reshape(b_, t_, GLA_HEADS * GLA_DV)
        return o * jax.nn.silu(g.astype(jnp.float32))

    ctx_in, g_ctx = prep(parts_ctx)
    lat_in, g_lat = prep(parts_lat)
    s0 = jnp.zeros((parts_lat[0].shape[0], GLA_HEADS, GLA_DK, GLA_DV), jnp.float32)
    o_ctx, o_lat = _bidirectional(_gla_chunked, ctx_in, lat_in, s0, with_ctx_out)
    return (finish(o_ctx, g_ctx) if with_ctx_out else None), finish(o_lat, g_lat)


def _gdn_mixer(parts_ctx, parts_lat, conv_w, a_log, dt_bias, norm_gain, with_ctx_out):
    def prep(parts):
        q, k, v, z, b, a = parts
        b_, t_, _ = q.shape
        qkv = jax.nn.silu(_depthwise_conv(jnp.concatenate([q, k, v], axis=-1), conv_w))
        q, k, v = jnp.split(qkv, [GDN_HEADS * GDN_DK, 2 * GDN_HEADS * GDN_DK], axis=-1)
        q = _l2norm(_heads(q, GDN_HEADS).astype(jnp.float32)) * GDN_DK ** -0.5
        k = _l2norm(_heads(k, GDN_HEADS).astype(jnp.float32))
        v = _heads(v, GDN_HEADS).astype(jnp.float32)
        beta = jax.nn.sigmoid(b.astype(jnp.float32)).reshape(b_, t_, 2, GDN_HEADS).transpose(2, 0, 3, 1)
        a = a.astype(jnp.float32).reshape(b_, t_, 2, GDN_HEADS).transpose(2, 0, 3, 1)
        g = -jnp.exp(a_log)[:, None, :, None] * jax.nn.softplus(a + dt_bias[:, None, :, None])
        return [(q, k, v, g[0], beta[0]), (q, k, v, g[1], beta[1])], z

    def finish(o, z):
        b_, _, t_, _ = o.shape
        o = _rms_norm(o.transpose(0, 2, 1, 3), norm_gain)
        o = o * jax.nn.silu(z.astype(jnp.float32).reshape(b_, t_, GDN_HEADS, GDN_DV))
        return o.reshape(b_, t_, GDN_HEADS * GDN_DV)

    ctx_in, z_ctx = prep(parts_ctx)
    lat_in, z_lat = prep(parts_lat)
    s0 = jnp.zeros((parts_lat[0].shape[0], GDN_HEADS, GDN_DK, GDN_DV), jnp.float32)
    o_ctx, o_lat = _bidirectional(_gdn_chunked, ctx_in, lat_in, s0, with_ctx_out)
    return (finish(o_ctx, z_ctx) if with_ctx_out else None), finish(o_lat, z_lat)


def _attend(q, k, v):
    s = jnp.einsum('bqhgd,bkhd->bhgqk', q, k).astype(jnp.float32) * HEAD_DIM ** -0.5
    p = jax.nn.softmax(s, axis=-1).astype(v.dtype)
    return jnp.einsum('bhgqk,bkhd->bqhgd', p, v)


def _gqa_mixer(parts_ctx, parts_lat, qk_gain, cos, sin, with_ctx_out):
    def prep(parts, rotary):
        q, k, v = parts
        b_, t_, _ = q.shape
        q = _rms_norm(q.reshape(b_, t_, ATTN_KV_HEADS, ATTN_GROUP, HEAD_DIM), qk_gain[0])
        k = _rms_norm(k.reshape(b_, t_, ATTN_KV_HEADS, HEAD_DIM), qk_gain[1])
        v = v.reshape(b_, t_, ATTN_KV_HEADS, HEAD_DIM).astype(jnp.float32)
        if rotary:
            q = _apply_axial_rope(q, cos, sin)
            k = _apply_axial_rope(k, cos, sin)
        return q, k, v

    q_c, k_c, v_c = prep(parts_ctx, False)
    q_l, k_l, v_l = prep(parts_lat, True)
    k_all = jnp.concatenate([k_c, k_l], axis=1)
    v_all = jnp.concatenate([v_c, v_l], axis=1)
    b_, n_, _, _, _ = q_l.shape
    nb = n_ // Q_BLOCK
    q_blocks = q_l.reshape(b_, nb, Q_BLOCK, ATTN_KV_HEADS, ATTN_GROUP, HEAD_DIM).transpose(1, 0, 2, 3, 4, 5)
    o_lat = lax.map(lambda qb: _attend(qb, k_all, v_all), q_blocks)
    o_lat = o_lat.transpose(1, 0, 2, 3, 4, 5).reshape(b_, n_, ATTN_HEADS * HEAD_DIM)
    o_ctx = None
    if with_ctx_out:
        o_ctx = _attend(q_c, k_c, v_c).reshape(b_, q_c.shape[1], ATTN_HEADS * HEAD_DIM)
    return o_ctx, o_lat


def _expert_choice_ffn(h, router, w1, w3, w2):
    b_, t_, _ = h.shape
    cap = EC_FACTOR * t_ // N_EXPERTS
    logits = jnp.einsum('btd,de->bet', h, router).astype(jnp.float32)
    aff = jax.nn.softmax(logits, axis=1)
    gate, idx = lax.top_k(aff, cap)
    bidx = jnp.arange(b_)[:, None, None]
    xs = h[bidx, idx]
    a = jnp.einsum('becd,edf->becf', xs, w1)
    u = jnp.einsum('becd,edf->becf', xs, w3)
    y = jnp.einsum('becf,efd->becd', jax.nn.silu(a) * u, w2) * gate[..., None].astype(h.dtype)
    return jnp.zeros_like(h).at[bidx, idx].add(y)


def setup_inputs(seed: int = 0) -> dict:
    key = jax.random.key(seed)
    ks = jax.random.split(key, 24)
    f32 = jnp.float32
    d = D_MODEL

    def nrm(k, shape, scale):
        return jax.random.normal(k, shape, f32) * scale

    dt = jnp.exp(jax.random.uniform(ks[10], (DEPTH, 2, GDN_HEADS), f32, math.log(1e-3), math.log(1e-1)))
    return {
        'x': nrm(ks[0], (BATCH, SEQ, d), 1.0),
        'c': nrm(ks[1], (BATCH, d), 1.0),
        'ctx': nrm(ks[2], (BATCH, CTX_LEN, d), 1.0),
        'c_ctx': nrm(ks[3], (d,), 1.0),
        'w_ada': nrm(ks[4], (DEPTH, d, N_MOD * d), 0.5 * d ** -0.5),
        'b_ada': nrm(ks[5], (DEPTH, N_MOD * d), 0.02),
        'w_in': nrm(ks[6], (DEPTH, d, IN_WIDTH), d ** -0.5),
        'w_out': nrm(ks[7], (DEPTH, MIX_WIDTH, d), DEEPNORM_BETA * MIX_WIDTH ** -0.5),
        'gla_w_up': nrm(ks[8], (DEPTH, 2, GLA_RANK, GLA_HEADS * GLA_DK), GLA_RANK ** -0.5),
        'gla_b_up': nrm(ks[9], (DEPTH, 2, GLA_HEADS * GLA_DK), 0.1),
        'gla_norm': 1.0 + nrm(ks[11], (DEPTH, GLA_DV), 0.02),
        'gdn_conv': nrm(ks[12], (DEPTH, GDN_CONV, GDN_CONV_CH), GDN_CONV ** -0.5),
        'gdn_a_log': jnp.log(jax.random.uniform(ks[13], (DEPTH, 2, GDN_HEADS), f32, 1.0, 16.0)),
        'gdn_dt_bias': dt + jnp.log(-jnp.expm1(-dt)),
        'gdn_norm': 1.0 + nrm(ks[14], (DEPTH, GDN_DV), 0.02),
        'attn_qk_norm': 1.0 + nrm(ks[15], (DEPTH, 2, HEAD_DIM), 0.02),
        'ln_gain': 1.0 + nrm(ks[16], (DEPTH, 2, d), 0.02),
        'ln_bias': nrm(ks[17], (DEPTH, 2, d), 0.02),
        'router': nrm(ks[18], (DEPTH, d, N_EXPERTS), d ** -0.5),
        'w1': nrm(ks[19], (DEPTH, N_EXPERTS, d, EXPERT_FF), d ** -0.5),
        'w3': nrm(ks[20], (DEPTH, N_EXPERTS, d, EXPERT_FF), d ** -0.5),
        'w2': nrm(ks[21], (DEPTH, N_EXPERTS, EXPERT_FF, d), DEEPNORM_BETA * EXPERT_FF ** -0.5),
    }


def reference(x, c, ctx, c_ctx, w_ada, b_ada, w_in, w_out, gla_w_up, gla_b_up, gla_norm,
              gdn_conv, gdn_a_log, gdn_dt_bias, gdn_norm, attn_qk_norm, ln_gain, ln_bias,
              router, w1, w3, w2):
    bsz, n_lat, d = x.shape
    cos, sin = _axial_rope_tables(n_lat)
    x_lat, x_ctx = x, ctx
    for l in range(DEPTH):
        last = l == DEPTH - 1
        mod_lat = (jax.nn.silu(c) @ w_ada[l] + b_ada[l]).reshape(bsz, N_MOD, 1, d)
        mod_ctx = (jax.nn.silu(c_ctx) @ w_ada[l] + b_ada[l]).reshape(N_MOD, 1, 1, d)

        p_lat = _split_cols(_modulate(x_lat, mod_lat[:, 0], mod_lat[:, 1]) @ w_in[l])
        p_ctx = _split_cols(_modulate(x_ctx, mod_ctx[0], mod_ctx[1]) @ w_in[l])
        gla_c, gla_l = _gla_mixer(p_ctx[0:5], p_lat[0:5], gla_w_up[l], gla_b_up[l], gla_norm[l], not last)
        gdn_c, gdn_l = _gdn_mixer(p_ctx[5:11], p_lat[5:11], gdn_conv[l], gdn_a_log[l], gdn_dt_bias[l],
                                  gdn_norm[l], not last)
        att_c, att_l = _gqa_mixer(p_ctx[11:14], p_lat[11:14], attn_qk_norm[l], cos, sin, not last)
        y_lat = jnp.concatenate([gla_l, gdn_l, att_l], axis=-1).astype(x_lat.dtype) @ w_out[l]
        x_lat = _layer_norm(DEEPNORM_ALPHA * x_lat + mod_lat[:, 2] * y_lat, ln_gain[l, 0], ln_bias[l, 0])
        if not last:
            y_ctx = jnp.concatenate([gla_c, gdn_c, att_c], axis=-1).astype(x_ctx.dtype) @ w_out[l]
            x_ctx = _layer_norm(DEEPNORM_ALPHA * x_ctx + mod_ctx[2] * y_ctx, ln_gain[l, 0], ln_bias[l, 0])

        f_lat = _expert_choice_ffn(_modulate(x_lat, mod_lat[:, 3], mod_lat[:, 4]), router[l], w1[l], w3[l], w2[l])
        x_lat = _layer_norm(DEEPNORM_ALPHA * x_lat + mod_lat[:, 5] * f_lat, ln_gain[l, 1], ln_bias[l, 1])
        if not last:
            f_ctx = _expert_choice_ffn(_modulate(x_ctx, mod_ctx[3], mod_ctx[4]), router[l], w1[l], w3[l], w2[l])
            x_ctx = _layer_norm(DEEPNORM_ALPHA * x_ctx + mod_ctx[5] * f_ctx, ln_gain[l, 1], ln_bias[l, 1])
    return x_lat
```

```cpp
#include <hip/hip_runtime.h>
#include <stdint.h>
#include <stdio.h>

#define DM 2048
#define NB 2
#define SEQ 4096
#define CTX 256
#define NLAT (NB * SEQ)
#define NCTX (NB * CTX)
#define NROW (NLAT + NCTX)
#define INW 5168
#define NMOD 6
#define NEXP 16
#define EFF 2048
#define CAP_L 512
#define CAP_C 32
#define SLOTS (2 * CAP_L + 2 * CAP_C)
#define C_GLA_Q 0
#define C_GLA_K 256
#define C_GLA_V 512
#define C_GLA_G 1024
#define C_GLA_R 1536
#define C_GDN_Q 1568
#define C_GDN_Z 3104
#define C_GDN_B 3616
#define C_GDN_A 3624
#define C_ATT_Q 3632
#define C_ATT_K 4656
#define C_ATT_V 4912

__device__ __forceinline__ float silu_f(float x) { return x / (1.f + __expf(-x)); }
__device__ __forceinline__ float sigmoid_f(float x) { return 1.f / (1.f + __expf(-x)); }
__device__ __forceinline__ float softplus_f(float x) { return fmaxf(x, 0.f) + log1pf(__expf(-fabsf(x))); }
__device__ __forceinline__ float logsigmoid_f(float x) { return fminf(x, 0.f) - log1pf(__expf(-fabsf(x))); }
__device__ __forceinline__ int stream_of_row(int r) { return r < SEQ ? 0 : (r < NLAT ? 1 : 2); }
__device__ __forceinline__ float wave_sum(float v) {
#pragma unroll
  for (int o = 32; o > 0; o >>= 1) v += __shfl_xor(v, o);
  return v;
}

struct GemmArgs { const float* A; const int* aidx; const float* B; float* C; int M, N, K, lda, ldb, ldc; long sA, sIdx, sB, sC; };
__global__ __launch_bounds__(256) void k_gemm(GemmArgs g) {
  __shared__ float As[16][68];
  __shared__ float Bs[16][68];
  const int z = blockIdx.z;
  const float* A = g.A + z * g.sA; const int* idx = g.aidx ? g.aidx + z * g.sIdx : nullptr;
  const float* B = g.B + z * g.sB; float* C = g.C + z * g.sC;
  const int m0 = blockIdx.y * 64, n0 = blockIdx.x * 64, tid = threadIdx.x, tx = tid & 15, ty = tid >> 4;
  float acc[4][4];
#pragma unroll
  for (int i = 0; i < 4; ++i)
#pragma unroll
    for (int j = 0; j < 4; ++j) acc[i][j] = 0.f;
  const int ar = tid >> 2, ak = (tid & 3) * 4;
  long aoff = -1; if (m0 + ar < g.M) { const int rr = idx ? idx[m0 + ar] : (m0 + ar); aoff = (long)rr * g.lda; }
  const int bk = tid >> 4, bn = (tid & 15) * 4;
  const bool bok = (n0 + bn) < g.N;
  for (int k0 = 0; k0 < g.K; k0 += 16) {
    float4 av = aoff >= 0 ? *(const float4*)(A + aoff + k0 + ak) : make_float4(0.f, 0.f, 0.f, 0.f);
    float4 bv = bok ? *(const float4*)(B + (long)(k0 + bk) * g.ldb + n0 + bn) : make_float4(0.f, 0.f, 0.f, 0.f);
    As[ak + 0][ar] = av.x; As[ak + 1][ar] = av.y; As[ak + 2][ar] = av.z; As[ak + 3][ar] = av.w;
    *(float4*)&Bs[bk][bn] = bv;
    __syncthreads();
#pragma unroll
    for (int kk = 0; kk < 16; ++kk) {
      const float4 a = *(const float4*)&As[kk][ty * 4]; const float4 b = *(const float4*)&Bs[kk][tx * 4];
      const float aa[4] = {a.x, a.y, a.z, a.w}, bb[4] = {b.x, b.y, b.z, b.w};
#pragma unroll
      for (int i = 0; i < 4; ++i)
#pragma unroll
        for (int j = 0; j < 4; ++j) acc[i][j] += aa[i] * bb[j];
    }
    __syncthreads();
  }
#pragma unroll
  for (int i = 0; i < 4; ++i) { const int m = m0 + ty * 4 + i; if (m >= g.M) continue;
    const int n = n0 + tx * 4; if (n < g.N) *(float4*)(C + (long)m * g.ldc + n) = make_float4(acc[i][0], acc[i][1], acc[i][2], acc[i][3]); }
}

__global__ __launch_bounds__(256) void k_ada(const float* c, const float* cctx, const float* w_ada, const float* b_ada, float* MOD) {
  __shared__ float sv[3][DM];
  const int tid = threadIdx.x, n = blockIdx.x * 256 + tid, l = blockIdx.y;
  for (int i = tid; i < DM; i += 256) { sv[0][i] = silu_f(c[i]); sv[1][i] = silu_f(c[DM + i]); sv[2][i] = silu_f(cctx[i]); }
  __syncthreads();
  const float* w = w_ada + (long)l * DM * (NMOD * DM) + n;
  float a0 = 0.f, a1 = 0.f, a2 = 0.f;
  for (int k = 0; k < DM; ++k) { const float wv = w[(long)k * (NMOD * DM)]; a0 += sv[0][k] * wv; a1 += sv[1][k] * wv; a2 += sv[2][k] * wv; }
  const float bb = b_ada[l * NMOD * DM + n];
  MOD[(l * 3 + 0) * (NMOD * DM) + n] = a0 + bb; MOD[(l * 3 + 1) * (NMOD * DM) + n] = a1 + bb; MOD[(l * 3 + 2) * (NMOD * DM) + n] = a2 + bb;
}

__global__ __launch_bounds__(256) void k_init(const float* x, const float* ctx, const float* MOD, float* X, float* H) {
  const int r = blockIdx.x, s = stream_of_row(r);
  const float* src = r < NLAT ? x + (long)r * DM : ctx + (long)(r - NLAT) * DM;
  const float* md = MOD + (0 * 3 + s) * (NMOD * DM);
  for (int j = threadIdx.x; j < DM; j += 256) { const float v = src[j]; X[(long)r * DM + j] = v; H[(long)r * DM + j] = v * (1.f + md[DM + j]) + md[j]; }
}

__global__ __launch_bounds__(256) void k_gla_gates(const float* P, const float* w_up, const float* b_up, float* LOGA) {
  const int r = blockIdx.x, z = blockIdx.y, k = threadIdx.x;
  float acc = b_up[z * 256 + k];
#pragma unroll
  for (int j = 0; j < 16; ++j) acc += P[(long)r * INW + C_GLA_R + z * 16 + j] * w_up[(z * 16 + j) * 256 + k];
  LOGA[((long)z * NROW + r) * 256 + k] = logsigmoid_f(acc) * (1.f / 16.f);
}
__global__ __launch_bounds__(128) void k_gla_scan(const float* P, const float* LOGA, float* OG) {
  const int b = blockIdx.x, h = blockIdx.y, dir = blockIdx.z, vt = threadIdx.x;
  float S[64];
#pragma unroll
  for (int k = 0; k < 64; ++k) S[k] = 0.f;
  for (int ph = 0; ph < 2; ++ph) {
    const int T = ph == 0 ? CTX : SEQ, row0 = ph == 0 ? NLAT + b * CTX : b * SEQ;
    for (int st = 0; st < T; ++st) {
      const int t = dir ? T - 1 - st : st; const long r = row0 + t;
      const float* pr = P + r * INW; const float* la = LOGA + ((long)dir * NROW + r) * 256 + h * 64;
      const float v = pr[C_GLA_V + h * 128 + vt];
      float o = 0.f;
#pragma unroll
      for (int k = 0; k < 64; ++k) { const float a = __expf(la[k]); S[k] = a * S[k] + pr[C_GLA_K + h * 64 + k] * v; o += pr[C_GLA_Q + h * 64 + k] * S[k]; }
      OG[((long)dir * NROW + r) * 512 + h * 128 + vt] = o * 0.125f;
    }
  }
}

__global__ __launch_bounds__(256) void k_gdn_conv(const float* P, const float* conv, float* QKVC) {
  const int r = blockIdx.x, ch = blockIdx.y * 256 + threadIdx.x;
  int start, len; if (r < NLAT) { start = (r / SEQ) * SEQ; len = SEQ; } else { start = NLAT + ((r - NLAT) / CTX) * CTX; len = CTX; }
  const int t = r - start; float acc = 0.f;
#pragma unroll
  for (int j = 0; j < 5; ++j) { const int tt = t + j - 2; if (tt >= 0 && tt < len) acc += P[(long)(start + tt) * INW + C_GDN_Q + ch] * conv[j * 1536 + ch]; }
  QKVC[(long)r * 1536 + ch] = silu_f(acc);
}
__global__ __launch_bounds__(512) void k_gdn_norm(const float* P, const float* a_log, const float* dt_bias, float* QKVC, float* BETA, float* GG) {
  const int r = blockIdx.x, w = threadIdx.x >> 6, lane = threadIdx.x & 63;
  float* p = QKVC + (long)r * 1536 + w * 128;
  const float x0 = p[lane], x1 = p[lane + 64];
  const float ss = wave_sum(x0 * x0 + x1 * x1);
  float sc = rsqrtf(ss + 1e-6f); if (w < 4) sc *= 0.08838834764831845f;
  p[lane] = x0 * sc; p[lane + 64] = x1 * sc;
  if (threadIdx.x < 8) { const int z = threadIdx.x >> 2, h = threadIdx.x & 3;
    BETA[((long)z * NROW + r) * 4 + h] = sigmoid_f(P[(long)r * INW + C_GDN_B + z * 4 + h]);
    GG[((long)z * NROW + r) * 4 + h] = -__expf(a_log[z * 4 + h]) * softplus_f(P[(long)r * INW + C_GDN_A + z * 4 + h] + dt_bias[z * 4 + h]); }
}
__global__ __launch_bounds__(128) void k_gdn_scan(const float* QKVC, const float* BETA, const float* GG, float* OD) {
  const int b = blockIdx.x, h = blockIdx.y, dir = blockIdx.z, vt = threadIdx.x;
  float S[128];
#pragma unroll
  for (int k = 0; k < 128; ++k) S[k] = 0.f;
  for (int ph = 0; ph < 2; ++ph) {
    const int T = ph == 0 ? CTX : SEQ, row0 = ph == 0 ? NLAT + b * CTX : b * SEQ;
    for (int st = 0; st < T; ++st) {
      const int t = dir ? T - 1 - st : st; const long r = row0 + t;
      const float* qr = QKVC + r * 1536 + h * 128; const float* kr = qr + 512; const float v = qr[1024 + vt];
      const float eg = __expf(GG[((long)dir * NROW + r) * 4 + h]), beta = BETA[((long)dir * NROW + r) * 4 + h];
      float kS = 0.f;
#pragma unroll
      for (int k = 0; k < 128; ++k) kS += kr[k] * S[k];
      const float vn = beta * (v - eg * kS);
      float o = 0.f;
#pragma unroll
      for (int k = 0; k < 128; ++k) { S[k] = eg * S[k] + kr[k] * vn; o += qr[k] * S[k]; }
      OD[((long)dir * NROW + r) * 512 + h * 128 + vt] = o;
    }
  }
}

__global__ __launch_bounds__(640) void k_attn_prep(const float* P, const float* qk_gain, float* QN, float* KN) {
  const int r = blockIdx.x, w = threadIdx.x >> 6, lane = threadIdx.x & 63;
  const bool isq = w < 8;
  const float* src = P + (long)r * INW + (isq ? C_ATT_Q + w * 128 : C_ATT_K + (w - 8) * 128);
  const float* gain = qk_gain + (isq ? 0 : 128);
  float x0 = src[lane], x1 = src[lane + 64];
  const float ss = wave_sum(x0 * x0 + x1 * x1);
  const float sc = rsqrtf(ss * (1.f / 128.f) + 1e-6f);
  x0 = x0 * sc * gain[lane]; x1 = x1 * sc * gain[lane + 64];
  if (r < NLAT) {
    const int t = r % SEQ, f = lane & 31; const float inv = powf(10000.f, -(float)f / 32.f);
    const float a0 = (float)(t / 64) * inv, a1 = (float)(t % 64) * inv;
    const float c0 = cosf(a0), s0 = sinf(a0), c1 = cosf(a1), s1 = sinf(a1);
    const float p0 = __shfl_xor(x0, 32), p1 = __shfl_xor(x1, 32);
    if (lane < 32) { x0 = x0 * c0 - p0 * s0; x1 = x1 * c1 - p1 * s1; } else { x0 = x0 * c0 + p0 * s0; x1 = x1 * c1 + p1 * s1; }
  }
  float* dst = isq ? QN + (long)r * 1024 + w * 128 : KN + (long)r * 256 + (w - 8) * 128;
  dst[lane] = x0; dst[lane + 64] = x1;
}
#define AQ 8
__global__ __launch_bounds__(256) void k_attn(const float* QN, const float* KN, const float* P, float* OA, int qrow_base, int qper_b, int nkeys) {
  extern __shared__ float sm[];
  float* qs = sm; float* sc = sm + AQ * 128; float* red = sc + AQ * nkeys;
  const int tid = threadIdx.x, hq = blockIdx.y, b = blockIdx.z, kvh = hq >> 2, q0 = qrow_base + b * qper_b + blockIdx.x * AQ;
  for (int i = tid; i < AQ * 128; i += 256) qs[i] = QN[(long)(q0 + (i >> 7)) * 1024 + hq * 128 + (i & 127)];
  __syncthreads();
  for (int j = tid; j < nkeys; j += 256) {
    const long kr = j < CTX ? NLAT + b * CTX + j : (long)b * SEQ + (j - CTX);
    const float4* kp = (const float4*)(KN + kr * 256 + kvh * 128);
    float d[AQ];
#pragma unroll
    for (int q = 0; q < AQ; ++q) d[q] = 0.f;
    for (int i = 0; i < 32; ++i) { const float4 kv = kp[i];
#pragma unroll
      for (int q = 0; q < AQ; ++q) { const float4 qv = *(const float4*)&qs[q * 128 + i * 4]; d[q] += kv.x * qv.x + kv.y * qv.y + kv.z * qv.z + kv.w * qv.w; } }
#pragma unroll
    for (int q = 0; q < AQ; ++q) sc[q * nkeys + j] = d[q] * 0.08838834764831845f;
  }
  __syncthreads();
  { const int w = tid >> 6, lane = tid & 63;
    for (int q = w; q < AQ; q += 4) {
      float m = -1e30f; for (int j = lane; j < nkeys; j += 64) m = fmaxf(m, sc[q * nkeys + j]);
#pragma unroll
      for (int o = 32; o > 0; o >>= 1) m = fmaxf(m, __shfl_xor(m, o));
      float s = 0.f; for (int j = lane; j < nkeys; j += 64) { const float e = __expf(sc[q * nkeys + j] - m); sc[q * nkeys + j] = e; s += e; }
      s = wave_sum(s); if (lane == 0) red[q] = 1.f / s; } }
  __syncthreads();
  { const int d = tid & 127, qh = tid >> 7; float acc[AQ / 2];
#pragma unroll
    for (int q = 0; q < AQ / 2; ++q) acc[q] = 0.f;
    for (int j = 0; j < nkeys; ++j) {
      const long kr = j < CTX ? NLAT + b * CTX + j : (long)b * SEQ + (j - CTX);
      const float v = P[kr * INW + C_ATT_V + kvh * 128 + d];
#pragma unroll
      for (int q = 0; q < AQ / 2; ++q) acc[q] += sc[(qh * (AQ / 2) + q) * nkeys + j] * v; }
#pragma unroll
    for (int q = 0; q < AQ / 2; ++q) OA[(long)(q0 + qh * (AQ / 2) + q) * 1024 + hq * 128 + d] = acc[q] * red[qh * (AQ / 2) + q]; }
}

__global__ __launch_bounds__(256) void k_mix(const float* P, const float* OG, const float* OD, const float* OA, const float* gla_norm, const float* gdn_norm, float* MIX) {
  const int r = blockIdx.x, w = threadIdx.x >> 6, lane = threadIdx.x & 63;
  { const long o0 = (long)r * 512 + w * 128, o1 = ((long)NROW + r) * 512 + w * 128;
    const float x0 = OG[o0 + lane] + OG[o1 + lane], x1 = OG[o0 + lane + 64] + OG[o1 + lane + 64];
    const float sc = rsqrtf(wave_sum(x0 * x0 + x1 * x1) * (1.f / 128.f) + 1e-6f);
    const float* g = P + (long)r * INW + C_GLA_G + w * 128;
    MIX[(long)r * DM + w * 128 + lane] = x0 * sc * gla_norm[lane] * silu_f(g[lane]);
    MIX[(long)r * DM + w * 128 + lane + 64] = x1 * sc * gla_norm[lane + 64] * silu_f(g[lane + 64]); }
  { const long o0 = (long)r * 512 + w * 128, o1 = ((long)NROW + r) * 512 + w * 128;
    const float x0 = OD[o0 + lane] + OD[o1 + lane], x1 = OD[o0 + lane + 64] + OD[o1 + lane + 64];
    const float sc = rsqrtf(wave_sum(x0 * x0 + x1 * x1) * (1.f / 128.f) + 1e-6f);
    const float* g = P + (long)r * INW + C_GDN_Z + w * 128;
    MIX[(long)r * DM + 512 + w * 128 + lane] = x0 * sc * gdn_norm[lane] * silu_f(g[lane]);
    MIX[(long)r * DM + 512 + w * 128 + lane + 64] = x1 * sc * gdn_norm[lane + 64] * silu_f(g[lane + 64]); }
  for (int j = threadIdx.x; j < 1024; j += 256) MIX[(long)r * DM + 1024 + j] = OA[(long)r * 1024 + j];
}

__global__ __launch_bounds__(256) void k_ln(float* X, const float* Y, const float* MOD, int l, int mgate, const float* gain, const float* bias, float* Hout, int lh, int mh, float* OUT) {
  __shared__ float red[8];
  const int r = blockIdx.x, s = stream_of_row(r), tid = threadIdx.x;
  const float* md = MOD + (l * 3 + s) * (NMOD * DM) + mgate * DM;
  float v[8]; float sum = 0.f;
#pragma unroll
  for (int i = 0; i < 8; ++i) { const int j = tid + i * 256; v[i] = 1.4142135623730951f * X[(long)r * DM + j] + md[j] * Y[(long)r * DM + j]; sum += v[i]; }
  sum = wave_sum(sum); if ((tid & 63) == 0) red[tid >> 6] = sum; __syncthreads();
  const float mean = (red[0] + red[1] + red[2] + red[3]) * (1.f / DM);
  float sq = 0.f;
#pragma unroll
  for (int i = 0; i < 8; ++i) { const float d = v[i] - mean; sq += d * d; }
  sq = wave_sum(sq); if ((tid & 63) == 0) red[4 + (tid >> 6)] = sq; __syncthreads();
  const float rstd = rsqrtf((red[4] + red[5] + red[6] + red[7]) * (1.f / DM) + 1e-5f);
  const float* mh_ = Hout ? MOD + (lh * 3 + s) * (NMOD * DM) + mh * DM : nullptr;
#pragma unroll
  for (int i = 0; i < 8; ++i) { const int j = tid + i * 256; const float o = (v[i] - mean) * rstd * gain[j] + bias[j];
    X[(long)r * DM + j] = o; if (OUT && r < NLAT) OUT[(long)r * DM + j] = o;
    if (Hout) Hout[(long)r * DM + j] = o * (1.f + mh_[DM + j]) + mh_[j]; }
}

__global__ __launch_bounds__(256) void k_router(const float* H, const float* router, float* AFF) {
  const int r = blockIdx.x * 4 + (threadIdx.x >> 6), lane = threadIdx.x & 63;
  float acc[NEXP];
#pragma unroll
  for (int e = 0; e < NEXP; ++e) acc[e] = 0.f;
  for (int j = lane; j < DM; j += 64) { const float h = H[(long)r * DM + j]; const float4* rp = (const float4*)(router + (long)j * NEXP);
#pragma unroll
    for (int q = 0; q < 4; ++q) { const float4 w = rp[q]; acc[q * 4 + 0] += h * w.x; acc[q * 4 + 1] += h * w.y; acc[q * 4 + 2] += h * w.z; acc[q * 4 + 3] += h * w.w; } }
  float m = -1e30f;
#pragma unroll
  for (int e = 0; e < NEXP; ++e) { acc[e] = wave_sum(acc[e]); m = fmaxf(m, acc[e]); }
  float s = 0.f;
#pragma unroll
  for (int e = 0; e < NEXP; ++e) { acc[e] = __expf(acc[e] - m); s += acc[e]; }
  if (lane < NEXP) { float v = 0.f;
#pragma unroll
    for (int e = 0; e < NEXP; ++e) v = (lane == e) ? acc[e] : v;
    AFF[(long)r * NEXP + lane] = v / s; }
}
__global__ __launch_bounds__(256) void k_topk(const float* AFF, int* ROWS, float* GATE, int row_base, int T, int cap, int slot_base) {
  extern __shared__ float vals[];
  const int e = blockIdx.y, b = blockIdx.z, row0 = row_base + b * T, tid = threadIdx.x;
  for (int i = tid; i < T; i += 256) vals[i] = AFF[(long)(row0 + i) * NEXP + e];
  __syncthreads();
  const int t = blockIdx.x * 256 + tid; const float mine = vals[t]; int rank = 0;
  for (int j = 0; j < T; ++j) { const float v = vals[j]; rank += (v > mine || (v == mine && j < t)) ? 1 : 0; }
  if (rank < cap) { const int slot = slot_base + b * cap + rank; ROWS[e * SLOTS + slot] = row0 + t; GATE[e * SLOTS + slot] = mine; }
}
__global__ __launch_bounds__(256) void k_swiglu(float* A1, const float* U1, long n) {
  for (long i = blockIdx.x * 256L + threadIdx.x; i < n; i += gridDim.x * 256L) A1[i] = silu_f(A1[i]) * U1[i];
}
__global__ __launch_bounds__(256) void k_zero(float* p, long n) { for (long i = blockIdx.x * 256L + threadIdx.x; i < n; i += gridDim.x * 256L) p[i] = 0.f; }
__global__ __launch_bounds__(256) void k_scatter(const float* YE, const int* ROWS, const float* GATE, float* F, int nslots) {
  const int slot = blockIdx.x, e = blockIdx.y; const int r = ROWS[e * SLOTS + slot]; const float g = GATE[e * SLOTS + slot];
  const float* y = YE + ((long)e * SLOTS + slot) * DM;
  for (int j = threadIdx.x; j < DM; j += 256) atomicAdd(&F[(long)r * DM + j], g * y[j]);
}

static void gemm(hipStream_t st, const float* A, const int* aidx, const float* B, float* C, int M, int N, int K, int lda, int ldb, int ldc,
                 int nz = 1, long sA = 0, long sIdx = 0, long sB = 0, long sC = 0) {
  GemmArgs g{}; g.A = A; g.aidx = aidx; g.B = B; g.C = C; g.M = M; g.N = N; g.K = K; g.lda = lda; g.ldb = ldb; g.ldc = ldc; g.sA = sA; g.sIdx = sIdx; g.sB = sB; g.sC = sC;
  hipLaunchKernelGGL(k_gemm, dim3((N + 63) / 64, (M + 63) / 64, nz), dim3(256), 0, st, g);
}

extern "C" void kernel_launch(void* const* d_in, const int* in_sizes, int n_in, void* d_out, int out_size, void* d_ws, size_t ws_size, hipStream_t stream) {
  const float* x = (const float*)d_in[0]; const float* c = (const float*)d_in[1]; const float* ctx = (const float*)d_in[2]; const float* c_ctx = (const float*)d_in[3];
  const float* w_ada = (const float*)d_in[4]; const float* b_ada = (const float*)d_in[5]; const float* w_in = (const float*)d_in[6]; const float* w_out = (const float*)d_in[7];
  const float* gla_w_up = (const float*)d_in[8]; const float* gla_b_up = (const float*)d_in[9]; const float* gla_norm = (const float*)d_in[10];
  const float* gdn_conv = (const float*)d_in[11]; const float* gdn_a_log = (const float*)d_in[12]; const float* gdn_dt_bias = (const float*)d_in[13]; const float* gdn_norm = (const float*)d_in[14];
  const float* attn_qk_norm = (const float*)d_in[15]; const float* ln_gain = (const float*)d_in[16]; const float* ln_bias = (const float*)d_in[17];
  const float* router = (const float*)d_in[18]; const float* w1 = (const float*)d_in[19]; const float* w3 = (const float*)d_in[20]; const float* w2 = (const float*)d_in[21];
  float* out = (float*)d_out;
  static int attr_done = 0;
  if (!attr_done) { hipFuncSetAttribute((const void*)k_attn, hipFuncAttributeMaxDynamicSharedMemorySize, 150000); attr_done = 1; }

  float* w = (float*)d_ws; size_t off = 0;
  auto take = [&](size_t n) { float* p = w + off; off += (n + 63) / 64 * 64; return p; };
  float* MOD = take(2 * 3 * NMOD * DM);
  float* X = take((size_t)NROW * DM); float* H = take((size_t)NROW * DM); float* Y = take((size_t)NROW * DM); float* MIX = take((size_t)NROW * DM); float* F = take((size_t)NROW * DM);
  float* P = take((size_t)NROW * INW);
  float* LOGA = take((size_t)2 * NROW * 256); float* OG = take((size_t)2 * NROW * 512); float* OD = take((size_t)2 * NROW * 512);
  float* QKVC = take((size_t)NROW * 1536); float* BETA = take((size_t)2 * NROW * 4); float* GG = take((size_t)2 * NROW * 4);
  float* QN = take((size_t)NROW * 1024); float* KN = take((size_t)NROW * 256); float* OA = take((size_t)NROW * 1024);
  float* AFF = take((size_t)NROW * NEXP); int* ROWS = (int*)take((size_t)NEXP * SLOTS); float* GATE = take((size_t)NEXP * SLOTS);
  float* A1 = take((size_t)NEXP * SLOTS * EFF); float* U1 = take((size_t)NEXP * SLOTS * EFF); float* YE = take((size_t)NEXP * SLOTS * DM);
  if (off * 4 > ws_size) { fprintf(stderr, "ws too small: need %zu have %zu\n", off * 4, ws_size); return; }

  hipLaunchKernelGGL(k_ada, dim3(NMOD * DM / 256, 2), dim3(256), 0, stream, c, c_ctx, w_ada, b_ada, MOD);
  hipLaunchKernelGGL(k_init, dim3(NROW), dim3(256), 0, stream, x, ctx, MOD, X, H);
  for (int l = 0; l < 2; ++l) {
    const bool last = l == 1;
    const int nrows = last ? NLAT : NROW;
    gemm(stream, H, nullptr, w_in + (size_t)l * DM * INW, P, NROW, INW, DM, DM, INW, INW);
    hipLaunchKernelGGL(k_gla_gates, dim3(NROW, 2), dim3(256), 0, stream, P, gla_w_up + (size_t)l * 2 * 16 * 256, gla_b_up + (size_t)l * 512, LOGA);
    hipLaunchKernelGGL(k_gla_scan, dim3(2, 4, 2), dim3(128), 0, stream, P, LOGA, OG);
    hipLaunchKernelGGL(k_gdn_conv, dim3(NROW, 6), dim3(256), 0, stream, P, gdn_conv + (size_t)l * 5 * 1536, QKVC);
    hipLaunchKernelGGL(k_gdn_norm, dim3(NROW), dim3(512), 0, stream, P, gdn_a_log + l * 8, gdn_dt_bias + l * 8, QKVC, BETA, GG);
    hipLaunchKernelGGL(k_gdn_scan, dim3(2, 4, 2), dim3(128), 0, stream, QKVC, BETA, GG, OD);
    hipLaunchKernelGGL(k_attn_prep, dim3(NROW), dim3(640), 0, stream, P, attn_qk_norm + (size_t)l * 256, QN, KN);
    { const int nk = CTX + SEQ; const size_t shm = (size_t)(AQ * 128 + AQ * nk + AQ) * 4;
      hipLaunchKernelGGL(k_attn, dim3(SEQ / AQ, 8, 2), dim3(256), shm, stream, QN, KN, P, OA, 0, SEQ, nk); }
    if (!last) { const int nk = CTX; const size_t shm = (size_t)(AQ * 128 + AQ * nk + AQ) * 4;
      hipLaunchKernelGGL(k_attn, dim3(CTX / AQ, 8, 2), dim3(256), shm, stream, QN, KN, P, OA, NLAT, CTX, nk); }
    hipLaunchKernelGGL(k_mix, dim3(nrows), dim3(256), 0, stream, P, OG, OD, OA, gla_norm + l * 128, gdn_norm + l * 128, MIX);
    gemm(stream, MIX, nullptr, w_out + (size_t)l * DM * DM, Y, nrows, DM, DM, DM, DM, DM);
    hipLaunchKernelGGL(k_ln, dim3(nrows), dim3(256), 0, stream, X, Y, MOD, l, 2, ln_gain + (size_t)(l * 2 + 0) * DM, ln_bias + (size_t)(l * 2 + 0) * DM, H, l, 3, (float*)nullptr);
    hipLaunchKernelGGL(k_router, dim3(nrows / 4), dim3(256), 0, stream, H, router + (size_t)l * DM * NEXP, AFF);
    hipLaunchKernelGGL(k_topk, dim3(SEQ / 256, NEXP, 2), dim3(256), SEQ * 4, stream, AFF, ROWS, GATE, 0, SEQ, CAP_L, 0);
    if (!last) hipLaunchKernelGGL(k_topk, dim3(CTX / 256, NEXP, 2), dim3(256), CTX * 4, stream, AFF, ROWS, GATE, NLAT, CTX, CAP_C, 2 * CAP_L);
    const int ns = last ? 2 * CAP_L : SLOTS;
    gemm(stream, H, ROWS, w1 + (size_t)l * NEXP * DM * EFF, A1, ns, EFF, DM, DM, EFF, EFF, NEXP, 0, SLOTS, (long)DM * EFF, (long)SLOTS * EFF);
    gemm(stream, H, ROWS, w3 + (size_t)l * NEXP * DM * EFF, U1, ns, EFF, DM, DM, EFF, EFF, NEXP, 0, SLOTS, (long)DM * EFF, (long)SLOTS * EFF);
    hipLaunchKernelGGL(k_swiglu, dim3(4096), dim3(256), 0, stream, A1, U1, (long)NEXP * SLOTS * EFF);
    gemm(stream, A1, nullptr, w2 + (size_t)l * NEXP * EFF * DM, YE, ns, DM, EFF, EFF, DM, DM, NEXP, (long)SLOTS * EFF, 0, (long)EFF * DM, (long)SLOTS * DM);
    hipLaunchKernelGGL(k_zero, dim3(4096), dim3(256), 0, stream, F, (long)NROW * DM);
    hipLaunchKernelGGL(k_scatter, dim3(ns, NEXP), dim3(256), 0, stream, YE, ROWS, GATE, F, ns);
    hipLaunchKernelGGL(k_ln, dim3(nrows), dim3(256), 0, stream, X, F, MOD, l, 5, ln_gain + (size_t)(l * 2 + 1) * DM, ln_bias + (size_t)(l * 2 + 1) * DM,
                       last ? (float*)nullptr : H, l + 1, 0, last ? out : (float*)nullptr);
  }
}
```

```cpp
#include <hip/hip_runtime.h>
#include <stdint.h>
#include <stdio.h>

#define DM 2048
#define NB 2
#define SEQ 4096
#define CTX 256
#define NLAT (NB * SEQ)
#define NCTX (NB * CTX)
#define NROW (NLAT + NCTX)
#define INW 5168
#define PW 5120
#define NINP 5376
#define NMOD 6
#define NEXP 16
#define EFF 2048
#define CAP_L 512
#define CAP_C 32
#define XSROWS 20480
#define C_GLA_Q 0
#define C_GLA_K 256
#define C_GLA_V 512
#define C_GLA_G 1024
#define C_GLA_R 1536
#define C_GDN_Q 1568
#define C_GDN_Z 3104
#define C_GDN_B 3616
#define C_GDN_A 3624
#define C_ATT_Q 3632
#define C_ATT_K 4656
#define C_ATT_V 4912

typedef unsigned short bf16_t;
__device__ __forceinline__ float silu_f(float x) { return x * __builtin_amdgcn_rcpf(1.f + __expf(-x)); }
__device__ __forceinline__ float sigmoid_f(float x) { return __builtin_amdgcn_rcpf(1.f + __expf(-x)); }
__device__ __forceinline__ float softplus_f(float x) { return fmaxf(x, 0.f) + log1pf(__expf(-fabsf(x))); }
__device__ __forceinline__ float logsigmoid_f(float x) { return fminf(x, 0.f) - log1pf(__expf(-fabsf(x))); }
__device__ __forceinline__ int stream_of_row(int r) { return r < SEQ ? 0 : (r < NLAT ? 1 : 2); }
__device__ __forceinline__ float wave_sum(float v) {
#define WS_DPP(CTRL, RMASK) __builtin_bit_cast(float, __builtin_amdgcn_update_dpp(0, __builtin_bit_cast(int, v), CTRL, RMASK, 0xF, false))
  v += WS_DPP(0xB1, 0xF); v += WS_DPP(0x4E, 0xF); v += WS_DPP(0x141, 0xF); v += WS_DPP(0x140, 0xF);
  v += WS_DPP(0x142, 0xA); v += WS_DPP(0x143, 0xC);
#undef WS_DPP
  return __builtin_bit_cast(float, __builtin_amdgcn_readlane(__builtin_bit_cast(int, v), 63));
}
typedef float f32x2c __attribute__((ext_vector_type(2)));
typedef __bf16 bf16x2c __attribute__((ext_vector_type(2)));
__device__ __forceinline__ unsigned pk2(float lo, float hi) { const f32x2c v = {lo, hi}; return __builtin_bit_cast(unsigned, __builtin_convertvector(v, bf16x2c)); }
__device__ __forceinline__ unsigned f2bf(float f) { return pk2(f, 0.f) & 0xffffu; }
__device__ __forceinline__ float bf2f(bf16_t b) { return __builtin_bit_cast(float, ((unsigned)b) << 16); }
__device__ __forceinline__ float Pget(const bf16_t* P, const float* PG, long r, int oc) {
  int nc;
  if (oc < 1536) nc = oc; else if (oc < 1568) return PG[r * 64 + (oc - 1536)]; else if (oc < 3616) nc = oc - 32;
  else if (oc < 3632) return PG[r * 64 + 32 + (oc - 3616)]; else nc = oc - 48;
  return bf2f(P[r * PW + nc]);
}
namespace pg8 {
#define PG8_LAS __attribute__((address_space(3)))
typedef unsigned short bf16_t;
typedef short bf16x8 __attribute__((ext_vector_type(8)));
typedef float f32x4 __attribute__((ext_vector_type(4)));
typedef unsigned u32x4 __attribute__((ext_vector_type(4)));
constexpr int BM = 256, BK = 64, HALF = 128, HTB = HALF * BK * 2  , STAGE_BYTES = 8 * HTB, NXCD = 8, WGM = 8;

__host__ __device__ __forceinline__ int lds_byte(int r, int c) { const int st = (r >> 4) * 2 + (c >> 5), rr = r & 15, cc = c & 31, ob = rr * 64 + cc * 2; return st * 1024 + (ob ^ (((ob >> 9) & 1) << 5)); }
__host__ __device__ __forceinline__ void stage_rc(int b, int& R, int& C) { const int st = b / 1024, sb = b % 1024, swz = sb ^ (((sb >> 9) & 1) << 5); R = (st >> 1) * 16 + swz / 64; C = (st & 1) * 32 + (swz % 64) / 2; }
__host__ __device__ __forceinline__ int perm32(int rho) { const int n = rho >> 4, i = rho & 15; return 8 * (i >> 2) + 4 * n + (i & 3); }

struct Unit { int pm, pn; };
struct Gemm { const bf16_t* A; const bf16_t* Bt; int M, N, K; };

struct StaticOrder {
    int nM, nN, nwg, G, c;
    __host__ __device__ void init(int M, int N, int G_, int c_) { nM = M / BM; nN = N / BM; nwg = nM * nN; G = G_; c = c_; }
    __host__ __device__ bool next(int i, Unit& u) const {
        const long L = (long)i * G + c; if (L >= nwg) return false;
        int wgid = (int)L; { const int q = nwg / NXCD, r = nwg % NXCD, xcd = wgid % NXCD, off = wgid / NXCD; wgid = (xcd < r ? xcd * (q + 1) : r * (q + 1) + (xcd - r) * q) + off; }
        const int nig = WGM * nN, gid = wgid / nig, fm = gid * WGM, gsz = (nM - fm) < WGM ? (nM - fm) : WGM;
        u.pm = fm + ((wgid % nig) % gsz); u.pn = (wgid % nig) / gsz; return true;
    }
    __device__ __forceinline__ void a_ready(const Unit&) const {}
    __device__ __forceinline__ void done(const Unit&) const {}
};
__device__ __forceinline__ unsigned cvt_pk_bf16(float lo, float hi) { return pk2(lo, hi); }
typedef float f32x2 __attribute__((ext_vector_type(2)));
struct EpiF32 {
    static constexpr bool PERM = false, AFTER_DRAIN = false;
    float* C; int ldc; const float* bias;
    __device__ __forceinline__ void operator()(const f32x4 (&acc)[2][2][4][2], const Unit& u, int wr, int wc, int fr, int fq) const {
        const int row0 = u.pm * BM + wr * 64 + fr, col0 = u.pn * BM + wc * 32 + 4 * fq;
        f32x4 bv[2][2];
#pragma unroll
        for (int bj = 0; bj < 2; ++bj)
#pragma unroll
            for (int n = 0; n < 2; ++n) bv[bj][n] = bias ? *(const f32x4*)(bias + col0 + bj * HALF + n * 16) : (f32x4){0.f, 0.f, 0.f, 0.f};
#pragma unroll
        for (int ai = 0; ai < 2; ++ai)
#pragma unroll
            for (int m = 0; m < 4; ++m) { float* rowp = C + (size_t)(row0 + ai * HALF + m * 16) * ldc + col0;
#pragma unroll
                for (int bj = 0; bj < 2; ++bj)
#pragma unroll
                    for (int n = 0; n < 2; ++n) *(f32x4*)(rowp + bj * HALF + n * 16) = acc[ai][bj][m][n] + bv[bj][n]; }
    }
};
struct EpiInProj {
    static constexpr bool PERM = true, AFTER_DRAIN = false;
    bf16_t* P; float* PG;
    __device__ __forceinline__ void operator()(const f32x4 (&acc)[2][2][4][2], const Unit& u, int wr, int wc, int fr, int fq) const {
        const int row0 = u.pm * BM + wr * 64 + fr;
        if (u.pn < 20) {
            const int col0 = u.pn * BM + wc * 32 + 8 * fq;
#pragma unroll
            for (int ai = 0; ai < 2; ++ai)
#pragma unroll
                for (int m = 0; m < 4; ++m) { bf16_t* rowp = P + (size_t)(row0 + ai * HALF + m * 16) * 5120 + col0;
#pragma unroll
                    for (int bj = 0; bj < 2; ++bj) { const f32x4 v0 = acc[ai][bj][m][0], v1 = acc[ai][bj][m][1];
                        u32x4 w; w.x = cvt_pk_bf16(v0[0], v0[1]); w.y = cvt_pk_bf16(v0[2], v0[3]); w.z = cvt_pk_bf16(v1[0], v1[1]); w.w = cvt_pk_bf16(v1[2], v1[3]);
                        *(u32x4*)(rowp + bj * HALF) = w; } }
        } else if (wc < 2) {
#pragma unroll
            for (int ai = 0; ai < 2; ++ai)
#pragma unroll
                for (int m = 0; m < 4; ++m) { float* rowp = PG + (size_t)(row0 + ai * HALF + m * 16) * 64 + wc * 32 + 8 * fq;
                    *(f32x4*)(rowp) = acc[ai][0][m][0]; *(f32x4*)(rowp + 4) = acc[ai][0][m][1]; }
        }
    }
};
struct EpiSwiGLU {
    static constexpr bool PERM = true, AFTER_DRAIN = false;
    bf16_t* HM;
    __device__ __forceinline__ float sg(float a, float b) const { return a * __builtin_amdgcn_rcpf(1.f + __expf(-a)) * b; }
    __device__ __forceinline__ void operator()(const f32x4 (&acc)[2][2][4][2], const Unit& u, int wr, int wc, int fr, int fq) const {
        const int row0 = u.pm * BM + wr * 64 + fr, col0 = (u.pn & 15) * HALF + wc * 32 + 8 * fq;
#pragma unroll
        for (int ai = 0; ai < 2; ++ai)
#pragma unroll
            for (int m = 0; m < 4; ++m) { bf16_t* rowp = HM + (size_t)(row0 + ai * HALF + m * 16) * 2048 + col0;
                const f32x4 a0 = acc[ai][0][m][0], a1 = acc[ai][0][m][1], b0 = acc[ai][1][m][0], b1 = acc[ai][1][m][1];
                u32x4 w; w.x = cvt_pk_bf16(sg(a0[0], b0[0]), sg(a0[1], b0[1])); w.y = cvt_pk_bf16(sg(a0[2], b0[2]), sg(a0[3], b0[3]));
                w.z = cvt_pk_bf16(sg(a1[0], b1[0]), sg(a1[1], b1[1])); w.w = cvt_pk_bf16(sg(a1[2], b1[2]), sg(a1[3], b1[3]));
                *(u32x4*)(rowp) = w; }
    }
};
struct EpiFfn2 {
    static constexpr bool PERM = true, AFTER_DRAIN = false;
    bf16_t* YE;
    __device__ __forceinline__ void operator()(const f32x4 (&acc)[2][2][4][2], const Unit& u, int wr, int wc, int fr, int fq) const {
        const int row0 = u.pm * BM + wr * 64 + fr, col0 = (u.pn & 7) * BM + wc * 32 + 8 * fq;
#pragma unroll
        for (int ai = 0; ai < 2; ++ai)
#pragma unroll
            for (int m = 0; m < 4; ++m) { bf16_t* rowp = YE + (size_t)(row0 + ai * HALF + m * 16) * 2048 + col0;
#pragma unroll
                for (int bj = 0; bj < 2; ++bj) { const f32x4 v0 = acc[ai][bj][m][0], v1 = acc[ai][bj][m][1];
                    u32x4 w; w.x = cvt_pk_bf16(v0[0], v0[1]); w.y = cvt_pk_bf16(v0[2], v0[3]); w.z = cvt_pk_bf16(v1[0], v1[1]); w.w = cvt_pk_bf16(v1[2], v1[3]);
                    *(u32x4*)(rowp + bj * HALF) = w; } }
    }
};
struct OrderFfn1 {
    int G, c, layer0;
    __device__ __forceinline__ bool next(int i, Unit& u) const {
        const long L = (long)i * G + c; const int total = layer0 ? 1280 : 1024; if (L >= total) return false;
        const int r = (int)(L >> 8), cc = (int)(L & 255), xcd = cc & 7, w = cc >> 3;
        if (r < 4) { const int e = 4 * r + (xcd >> 1), ii = w & 3, j = (xcd & 1) * 8 + (w >> 2); u.pm = e * 4 + ii; u.pn = e * 16 + j; }
        else { const int e = 2 * xcd + (w >> 4), j = w & 15; u.pm = 64 + e; u.pn = e * 16 + j; }
        return true; }
    __device__ __forceinline__ void a_ready(const Unit&) const {}
    __device__ __forceinline__ void done(const Unit&) const {}
};
struct OrderFfn2 {
    int G, c, layer0;
    __device__ __forceinline__ bool next(int i, Unit& u) const {
        const long L = (long)i * G + c; const int total = layer0 ? 640 : 512; if (L >= total) return false;
        const int r = (int)(L >> 8), cc = (int)(L & 255), xcd = cc & 7, w = cc >> 3;
        if (r < 2) { const int e = 8 * r + xcd, ii = w & 3, j = w >> 2; u.pm = e * 4 + ii; u.pn = e * 8 + j; }
        else { const int e = 2 * xcd + (w >> 3), j = w & 7; u.pm = 64 + e; u.pn = e * 8 + j; }
        return true; }
    __device__ __forceinline__ void a_ready(const Unit&) const {}
    __device__ __forceinline__ void done(const Unit&) const {}
};
template <class Epi, class Sched, bool STAMP = false>
__device__ __forceinline__ void gemm_phase(PG8_LAS unsigned char* lds, const Gemm g, const Sched& S, const Epi& E, unsigned long long* stamps) {
    int tid_ = threadIdx.x; asm volatile("" : "+v"(tid_));
    const int tid = tid_, wid = __builtin_amdgcn_readfirstlane(tid >> 6), lane = tid & 63, wr = wid >> 2, wc = wid & 3, fr = lane & 15, fq = lane >> 4;
    const int K = g.K, nt = K / BK;
    int ts_lo = 0, ts_hi = 0, nts = 0; const unsigned long long rt_entry = STAMP ? (unsigned long long)wall_clock64() : 0ull;
#define PG8_STAMP() do { if (STAMP && wid == 0 && nts < 64) { const unsigned long long _c = (unsigned long long)clock64(); \
        ts_lo = (lane == nts) ? (int)(unsigned)_c : ts_lo; ts_hi = (lane == nts) ? (int)(unsigned)(_c >> 32) : ts_hi; ++nts; } } while (0)
    PG8_STAMP();
    unsigned voffA[2], voffB[2];
#pragma unroll
    for (int i = 0; i < 2; ++i) { int R, C; stage_rc(tid * 16 + i * 8192, R, C); const int Rb = Epi::PERM ? ((R & ~31) + perm32(R & 31)) : R;
        voffA[i] = (unsigned)(R * K + C) * 2u; voffB[i] = (unsigned)(Rb * K + C) * 2u; }
    const size_t kstep = (size_t)(BK * 2);
    const size_t hstep = (size_t)HALF * K * 2;
    const size_t tstep = 2 * hstep;
    const unsigned ldsw = (unsigned)wid * 1024u;
    const int aoff = lds_byte(wr * 64 + fr, fq * 8), boff = lds_byte(wc * 32 + fr, fq * 8);
#define PG8_SA(b, h) (((b) * 2 + (h)) * HTB)
#define PG8_SB(b, h) ((4 + (b) * 2 + (h)) * HTB)
#define PG8_STAGE(bufoff, gbase, voff) do { _Pragma("unroll") for (int _i = 0; _i < 2; ++_i) \
        __builtin_amdgcn_global_load_lds((const unsigned*)((const char*)(gbase) + (voff)[_i]), (PG8_LAS unsigned*)(lds + (bufoff) + ldsw + _i * 8192), 16, 0, 0); } while (0)
#define PG8_LDA(dst, b, h) do { _Pragma("unroll") for (int m = 0; m < 4; ++m) _Pragma("unroll") for (int k = 0; k < 2; ++k) dst[m][k] = *(const PG8_LAS bf16x8*)(lds + PG8_SA(b, h) + aoff + m * 2048 + k * 1024); } while (0)
#define PG8_LDB(dst, b, h) do { _Pragma("unroll") for (int n = 0; n < 2; ++n) _Pragma("unroll") for (int k = 0; k < 2; ++k) dst[n][k] = *(const PG8_LAS bf16x8*)(lds + PG8_SB(b, h) + boff + n * 2048 + k * 1024); } while (0)
#define PG8_MMA(ai, bj, At, Bt) do { __builtin_amdgcn_s_setprio(1); _Pragma("unroll") for (int m = 0; m < 4; ++m) _Pragma("unroll") for (int n = 0; n < 2; ++n) _Pragma("unroll") for (int k = 0; k < 2; ++k) \
        acc[ai][bj][m][n] = __builtin_amdgcn_mfma_f32_16x16x32_bf16(Bt[n][k], At[m][k], acc[ai][bj][m][n], 0, 0, 0); __builtin_amdgcn_s_setprio(0); } while (0)
#define PG8_WAIT_V(n) asm volatile("s_waitcnt vmcnt(" #n ")" ::: "memory")
#define PG8_WAIT_L(n) asm volatile("s_waitcnt lgkmcnt(" #n ")" ::: "memory")
#define PG8_BAR __builtin_amdgcn_s_barrier()
#define PG8_SCHED __builtin_amdgcn_sched_barrier(0)
    Unit cur, nxt; int ui = 0;
    if (!S.next(0, cur)) return;
    f32x4 acc[2][2][4][2];
#pragma unroll
    for (int a = 0; a < 2; ++a)
#pragma unroll
        for (int b = 0; b < 2; ++b)
#pragma unroll
            for (int m = 0; m < 4; ++m)
#pragma unroll
                for (int n = 0; n < 2; ++n) acc[a][b][m][n] = (f32x4){0.f, 0.f, 0.f, 0.f};
    bf16x8 At[4][2], B0[2][2], B1[2][2];
    const char* cA = (const char*)g.A + (size_t)cur.pm * tstep; const char* cB = (const char*)g.Bt + (size_t)cur.pn * tstep;
    S.a_ready(cur);
    PG8_STAGE(PG8_SB(0, 0), cB, voffB); PG8_STAGE(PG8_SA(0, 0), cA, voffA); PG8_STAGE(PG8_SB(0, 1), cB + hstep, voffB); PG8_STAGE(PG8_SA(0, 1), cA + hstep, voffA);
    if (wr == 1) PG8_BAR;
    PG8_WAIT_V(4); PG8_BAR;
    PG8_STAGE(PG8_SB(1, 0), cB + kstep, voffB); PG8_STAGE(PG8_SA(1, 0), cA + kstep, voffA); PG8_STAGE(PG8_SB(1, 1), cB + hstep + kstep, voffB);
    PG8_WAIT_V(6); PG8_BAR;
    PG8_STAMP();
    for (;;) {
        const bool has_next = S.next(ui + 1, nxt);
        const char* nA = has_next ? (const char*)g.A + (size_t)nxt.pm * tstep : cA; const char* nB = has_next ? (const char*)g.Bt + (size_t)nxt.pn * tstep : cB;
        for (int t = 0; t < nt; t += 2) {
            const bool last = (t == nt - 2);
            const char* a1 = cA + (size_t)(t + 1) * kstep;
            const char* a2 = last ? nA : cA + (size_t)(t + 2) * kstep; const char* b2 = last ? nB : cB + (size_t)(t + 2) * kstep;
            const char* a3 = a2 + kstep; const char* b3 = b2 + kstep;
            if (last && has_next) S.a_ready(nxt);
            PG8_LDB(B0, 0, 0); PG8_SCHED; PG8_LDA(At, 0, 0); PG8_STAGE(PG8_SA(1, 1), a1 + hstep, voffA);
            PG8_WAIT_L(8); PG8_BAR; PG8_WAIT_L(0); PG8_MMA(0, 0, At, B0); PG8_BAR; PG8_SCHED;
            PG8_LDB(B1, 0, 1); PG8_STAGE(PG8_SB(0, 0), b2, voffB);
            PG8_BAR; PG8_WAIT_L(0); PG8_MMA(0, 1, At, B1); PG8_BAR;
            PG8_LDA(At, 0, 1); PG8_STAGE(PG8_SA(0, 0), a2, voffA);
            PG8_BAR; PG8_WAIT_L(0); PG8_MMA(1, 0, At, B0); PG8_BAR; PG8_SCHED;
            PG8_STAGE(PG8_SB(0, 1), b2 + hstep, voffB);
            PG8_WAIT_V(6); PG8_BAR; PG8_MMA(1, 1, At, B1); PG8_BAR;
            PG8_LDB(B0, 1, 0); PG8_SCHED; PG8_LDA(At, 1, 0); PG8_STAGE(PG8_SA(0, 1), a2 + hstep, voffA);
            PG8_WAIT_L(8); PG8_BAR; PG8_WAIT_L(0); PG8_MMA(0, 0, At, B0); PG8_BAR; PG8_SCHED;
            PG8_LDB(B1, 1, 1); PG8_STAGE(PG8_SB(1, 0), b3, voffB);
            PG8_BAR; PG8_WAIT_L(0); PG8_MMA(0, 1, At, B1); PG8_BAR;
            PG8_LDA(At, 1, 1); PG8_STAGE(PG8_SA(1, 0), a3, voffA);
            PG8_BAR; PG8_WAIT_L(0); PG8_MMA(1, 0, At, B0); PG8_BAR; PG8_SCHED;
            PG8_STAGE(PG8_SB(1, 1), b3 + hstep, voffB);
            PG8_WAIT_V(6); PG8_BAR; PG8_MMA(1, 1, At, B1); PG8_BAR;
        }
        PG8_STAMP();
        if constexpr (!Epi::AFTER_DRAIN) { E(acc, cur, wr, wc, fr, fq); S.done(cur); }
        PG8_STAMP();
        if (!has_next) break;
#pragma unroll
        for (int a = 0; a < 2; ++a)
#pragma unroll
            for (int b = 0; b < 2; ++b)
#pragma unroll
                for (int m = 0; m < 4; ++m)
#pragma unroll
                    for (int n = 0; n < 2; ++n) acc[a][b][m][n] = (f32x4){0.f, 0.f, 0.f, 0.f};
        cur = nxt; cA = nA; cB = nB; ++ui;
    }
    PG8_WAIT_V(0);
    if (wr == 0) PG8_BAR;
    PG8_BAR;
    if constexpr (Epi::AFTER_DRAIN) { E.fused(acc, cur, wr, wc, fr, fq, lds, wid, lane); S.done(cur); }
    PG8_STAMP();
    if (STAMP && wid == 0) { stamps[lane] = lane < nts ? (((unsigned long long)(unsigned)ts_hi << 32) | (unsigned)ts_lo) : 0ull;
        if (lane == 62) stamps[62] = rt_entry; if (lane == 63) stamps[63] = (unsigned long long)wall_clock64(); }
#undef PG8_STAMP
#undef PG8_SA
#undef PG8_SB
#undef PG8_STAGE
#undef PG8_LDA
#undef PG8_LDB
#undef PG8_MMA
#undef PG8_WAIT_V
#undef PG8_WAIT_L
#undef PG8_BAR
#undef PG8_SCHED
}
}
#define XB_TMO      128
#define XB_XCNT(j)  (256  + 64 * (j))
#define XB_XSUB(j)  (1280 + 64 * (j))
#define XB_XGEN(j)  (2304 + 64 * (j))
#define XB_TOP      3328
#define XB_TOPGEN   3392
#define XCD_BAR_WORDS 3456
#define XB_SPIN_CAP (1u << 18)
#define LAS __attribute__((address_space(3)))

__device__ __forceinline__ unsigned xb_ld(unsigned* p)              { return __hip_atomic_load(p, __ATOMIC_RELAXED, __HIP_MEMORY_SCOPE_AGENT); }
__device__ __forceinline__ unsigned xb_add(unsigned* p, unsigned v) { return __hip_atomic_fetch_add(p, v, __ATOMIC_RELAXED, __HIP_MEMORY_SCOPE_AGENT); }
__device__ __forceinline__ unsigned xb_xcc_id() { return (unsigned)__builtin_amdgcn_s_getreg((3 << 11) | 20) & 0xFu; }
#define XB_SPIN(cond, bar) do { unsigned _sp = 0; while (cond) { __builtin_amdgcn_s_sleep(1); \
    if ((++_sp & 255u) == 0u) { if (xb_ld(&(bar)[XB_TMO])) break; if (_sp > XB_SPIN_CAP) { atomicAdd(&(bar)[XB_TMO], 1u); break; } } } } while (0)

struct XcdBarrier {
    unsigned* bar; unsigned x;
    volatile LAS unsigned* st;
};

__device__ __forceinline__ XcdBarrier xcd_barrier_post(unsigned* bar, volatile LAS unsigned* st) {
    XcdBarrier b; b.bar = bar; b.x = xb_xcc_id(); b.st = st;
    if (threadIdx.x == 0) (void)xb_add(&bar[XB_XCNT(b.x)], 1u);
    return b;
}
__device__ __forceinline__ void xcd_barrier_complete(unsigned* bar, unsigned x, unsigned& nloc, unsigned& nx) {
    const unsigned G = gridDim.x * gridDim.y * gridDim.z;
    unsigned sum, cnt, mine, sp = 0u;
    for (;;) {
        sum = 0u; cnt = 0u; mine = 0u;
#pragma unroll
        for (unsigned j = 0; j < 16; ++j) { const unsigned c = xb_ld(&bar[XB_XCNT(j)]); sum += c; cnt += (c > 0u) ? 1u : 0u; mine = (j == x) ? c : mine; }
        if (sum == G) break;
        __builtin_amdgcn_s_sleep(1);
        if ((++sp & 255u) == 0u) { if (xb_ld(&bar[XB_TMO])) break; if (sp > XB_SPIN_CAP) { atomicAdd(&bar[XB_TMO], 1u); break; } }
    }
    nloc = mine > 0u ? mine : 1u; nx = cnt > 0u ? cnt : 1u;
}

__device__ __forceinline__ void xcd_barrier(const XcdBarrier& b) {
    asm volatile("s_waitcnt vmcnt(0)" ::: "memory");
    __syncthreads();
    if (threadIdx.x == 0) {
        unsigned* bar = b.bar;
        __builtin_amdgcn_s_waitcnt(0);
        unsigned nloc = b.st[0], nx = b.st[1];
        if (nloc == 0u) { xcd_barrier_complete(bar, b.x, nloc, nx); b.st[0] = nloc; b.st[1] = nx; }
        const unsigned old = xb_add(&bar[XB_XSUB(b.x)], 1u);
        const unsigned gen = old / nloc;
        if (old + 1u == (gen + 1u) * nloc) {
            __builtin_amdgcn_fence(__ATOMIC_RELEASE, "agent");
            asm volatile("s_waitcnt vmcnt(0)" ::: "memory");
            const unsigned og = xb_add(&bar[XB_TOP], 1u);
            const unsigned tg = og / nx;
            if (og + 1u == (tg + 1u) * nx) xb_add(&bar[XB_TOPGEN], 1u);
            else XB_SPIN(xb_ld(&bar[XB_TOPGEN]) == tg, bar);
            __builtin_amdgcn_fence(__ATOMIC_ACQUIRE, "agent");
            xb_add(&bar[XB_XGEN(b.x)], 1u);
            asm volatile("s_waitcnt vmcnt(0)" ::: "memory");
        } else {
            XB_SPIN(xb_ld(&bar[XB_XGEN(b.x)]) == gen, bar);
            __builtin_amdgcn_fence(__ATOMIC_ACQUIRE, "agent");
            asm volatile("s_waitcnt vmcnt(0)" ::: "memory");
        }
    }
    __syncthreads();
}
#define LAS __attribute__((address_space(3)))
#define GAS __attribute__((address_space(1)))
typedef unsigned v4u __attribute__((ext_vector_type(4)));
#define LDS_WAIT() asm volatile("s_waitcnt lgkmcnt(0)" ::: "memory")
#define VM_WAIT() asm volatile("s_waitcnt vmcnt(0)" ::: "memory")
#define LDS_BAR() do { asm volatile("s_waitcnt lgkmcnt(0)" ::: "memory"); __builtin_amdgcn_s_barrier(); asm volatile("" ::: "memory"); } while (0)
constexpr int RING_BYTES = 131072, LDSCTL_OFF = RING_BYTES, MISC_OFF = LDSCTL_OFF + 320, LDS_BYTES = 147456, NWAVES = 8;
constexpr int CW_BAR = 4096;
constexpr size_t CTL_ZERO_BYTES = 1u << 20;
constexpr int NPH_PRO = 2, NPH_LAYER = 11, NPH = NPH_PRO + 2 * NPH_LAYER;
enum { PH_CONV = 0, PH_INIT = 1, L_INPROJ = 0, L_PREP = 1, L_CHUNK = 2, L_SCAN = 3, L_OUT = 4, L_OPROJ = 5, L_LN1 = 6, L_TOPK = 7, L_FFN1 = 8, L_FFN2 = 9, L_LN2 = 10 };

struct Args {
    const float *x, *c, *ctx, *c_ctx, *w_ada, *b_ada, *w_in, *w_out, *gla_w_up, *gla_b_up, *gla_norm, *gdn_conv, *gdn_a_log, *gdn_dt_bias, *gdn_norm,
                *attn_qk_norm, *ln_gain, *ln_bias, *router, *w1, *w3, *w2;
    float* out; unsigned* ctl; float* MOD;
    bf16_t *WinT, *WoutT, *W13T, *W2T;
    float* X; bf16_t* HB; bf16_t* P; float* PG; float* Y; bf16_t* MIXB; bf16_t *XS, *HM, *YE;
    float *ROPE, *AFF, *AFFT; int* SEL;
    bf16_t *QB, *KB, *VB, *GQKV; float *BETA, *GG;
    float *GKV, *GDL; bf16_t* GST;
    bf16_t *WG, *KDTG, *QDG, *AIG, *SPREV, *VNEW; float *UG, *DLASTG;
    int ph_lo, ph_hi, li, pad;
};
typedef const __attribute__((address_space(4))) Args* KA;
constexpr size_t WINT_L = (size_t)NINP * DM, WOUTT_L = (size_t)DM * DM, W13T_L = (size_t)NEXP * 4096 * DM, W2T_L = (size_t)NEXP * DM * EFF;

__device__ __forceinline__ void transpose_item(const float* src, int ldn, int nvalid, bf16_t* dst, int K, int k0, LAS float* scr, int lane) {
    const int x = lane & 31; const bool ok = x < nvalid;
#pragma unroll 8
    for (int i = 0; i < 32; ++i) { const int kk = 2 * i + (lane >> 5); scr[kk * 33 + x] = ok ? src[(size_t)(k0 + kk) * ldn + x] : 0.f; }
    LDS_WAIT(); asm volatile("" ::: "memory");
    const int c = lane & 7;
#pragma unroll
    for (int j = 0; j < 4; ++j) { const int n = (lane >> 3) + 8 * j; const LAS float* s = scr + (8 * c) * 33 + n;
        v4u o; o.x = pk2(s[0 * 33], s[1 * 33]); o.y = pk2(s[2 * 33], s[3 * 33]); o.z = pk2(s[4 * 33], s[5 * 33]); o.w = pk2(s[6 * 33], s[7 * 33]);
        *(GAS v4u*)(dst + (size_t)n * K + k0 + 8 * c) = o; }
    LDS_WAIT(); asm volatile("" ::: "memory");
}
typedef float f32x4v __attribute__((ext_vector_type(4)));
constexpr int CV_IN = 32 * (NINP / 64), CV_OUT = 32 * (DM / 64), CV_13 = 32 * (NEXP * 4096 / 64), CV_2 = 32 * (NEXP * DM / 64), CV_L = CV_IN + CV_OUT + CV_13 + CV_2;
constexpr int CONV_NALL = 2 * CV_L;
constexpr int CONV_QA = 14000, CONV_QB = 7000, CONV_QC = 4000, CONV_QE = 14000;
constexpr int CONV_N0 = CONV_NALL - CONV_QA - CONV_QB - CONV_QC - CONV_QE, CONV_NA = CONV_N0 + CONV_QA, CONV_NB = CONV_NA + CONV_QB, CONV_NC = CONV_NB + CONV_QC;
__device__ __forceinline__ int in_src_col(int np) {
    if (np < 1536) return np; if (np < 3584) return np + 32; if (np < 5120) return np + 48; if (np < 5152) return 1536 + (np - 5120); if (np < 5168) return 3616 + (np - 5152); return -1;
}
__device__ __forceinline__ void conv_range(KA a, LAS unsigned char* lds, int wave, int lane, int it_begin, int it_end, int widx, int nw) {
    LAS float* tile = (LAS float*)(lds + wave * 16384);
    const int gw = widx * NWAVES + wave, NGW = nw * NWAVES;
    const int kq = lane >> 4, n4 = (lane & 15) * 4;
#define CONV_DECODE(it_, SRC, DST, LDN, KK, K0) do { const int l_ = (it_) / CV_L; int r_ = (it_) % CV_L; \
        if (r_ < CV_IN) { const int db = r_ >> 5, kb = r_ & 31; const int sc_ = in_src_col(64 * db + n4); \
            SRC = sc_ >= 0 ? a->w_in + (size_t)l_ * DM * INW + sc_ : (const float*)nullptr; LDN = INW; DST = a->WinT + l_ * WINT_L + (size_t)(64 * db) * DM; KK = DM; K0 = 64 * kb; } \
        else if ((r_ -= CV_IN) < CV_OUT) { const int db = r_ >> 5, kb = r_ & 31; \
            SRC = a->w_out + (size_t)l_ * DM * DM + 64 * db + n4; LDN = DM; DST = a->WoutT + l_ * WOUTT_L + (size_t)(64 * db) * DM; KK = DM; K0 = 64 * kb; } \
        else if ((r_ -= CV_OUT) < CV_13) { const int db = r_ >> 5, kb = r_ & 31, e = db >> 6, q = db & 63, j = q >> 2, bj = (q >> 1) & 1, xb = q & 1; \
            SRC = (bj ? a->w3 : a->w1) + ((size_t)l_ * NEXP + e) * DM * EFF + 128 * j + 64 * xb + n4; LDN = EFF; DST = a->W13T + l_ * W13T_L + (size_t)(64 * db) * DM; KK = DM; K0 = 64 * kb; } \
        else { r_ -= CV_13; const int db = r_ >> 5, kb = r_ & 31, e = db >> 5, nb = db & 31; \
            SRC = a->w2 + ((size_t)l_ * NEXP + e) * EFF * DM + 64 * nb + n4; LDN = DM; DST = a->W2T + l_ * W2T_L + (size_t)(64 * db) * EFF; KK = EFF; K0 = 64 * kb; } } while (0)
#define CONV_LOAD(R, SRC, LDN, K0) do { const float* p_ = (SRC) ? (SRC) + (size_t)((K0) + kq) * (LDN) : (const float*)nullptr; \
        _Pragma("unroll") for (int i = 0; i < 16; ++i) R[i] = p_ ? __builtin_nontemporal_load((const f32x4v*)(p_ + (size_t)(4 * i) * (LDN))) : (f32x4v){0.f, 0.f, 0.f, 0.f}; } while (0)
    int it = it_begin + gw;
    if (it < it_end) {
        const float* src; bf16_t* dst; int ldn, KK, k0; f32x4v r[16];
        CONV_DECODE(it, src, dst, ldn, KK, k0); CONV_LOAD(r, src, ldn, k0);
        for (;;) {
            const int nit = it + NGW; const bool more = nit < it_end;
            const float* nsrc = src; bf16_t* ndst = dst; int nldn = ldn, nKK = KK, nk0 = k0; f32x4v rn[16];
            if (more) { CONV_DECODE(nit, nsrc, ndst, nldn, nKK, nk0); CONV_LOAD(rn, nsrc, nldn, nk0); }
#pragma unroll
            for (int i = 0; i < 16; ++i) { const int kk = 4 * i + kq; *(LAS f32x4v*)(tile + kk * 64 + ((((lane & 15)) ^ ((kk >> 3) & 7)) << 2)) = r[i]; }
            LDS_WAIT(); asm volatile("" ::: "memory");
            { const int kc = lane & 7;
#pragma unroll
              for (int j = 0; j < 8; ++j) { const int n = (lane >> 3) + 8 * j; const LAS float* sp = tile + (8 * kc) * 64 + ((((n >> 2)) ^ kc) << 2) + (n & 3);
                  v4u o; o.x = pk2(sp[0 * 64], sp[1 * 64]); o.y = pk2(sp[2 * 64], sp[3 * 64]); o.z = pk2(sp[4 * 64], sp[5 * 64]); o.w = pk2(sp[6 * 64], sp[7 * 64]);
                  __builtin_nontemporal_store(o, (GAS v4u*)(dst + (size_t)n * KK + k0 + 8 * kc)); } }
            LDS_WAIT(); asm volatile("" ::: "memory");
            if (!more) break;
            it = nit; src = nsrc; dst = ndst; ldn = nldn; KK = nKK; k0 = nk0;
#pragma unroll
            for (int i = 0; i < 16; ++i) r[i] = rn[i];
        }
    }
#undef CONV_DECODE
#undef CONV_LOAD
}
__device__ __forceinline__ void phase_convert(KA a, LAS unsigned char* lds, int wave, int lane) {
    { LAS float* sv = (LAS float*)lds; LAS float* part = sv + 3 * DM;
      const int tid = wave * 64 + lane, n = tid & 127, kg = tid >> 7;
      for (int unit = blockIdx.x; unit < 2 * 96; unit += gridDim.x) {
        const int l = unit / 96, n0 = (unit % 96) * 128;
        for (int i = tid; i < DM; i += 512) { sv[i] = silu_f(a->c[i]); sv[DM + i] = silu_f(a->c[DM + i]); sv[2 * DM + i] = silu_f(a->c_ctx[i]); }
        __syncthreads();
        const float* w = a->w_ada + (size_t)l * DM * (NMOD * DM) + n0 + n;
        float a0 = 0.f, a1 = 0.f, a2 = 0.f;
#pragma unroll 8
        for (int k = kg * 512; k < kg * 512 + 512; ++k) { const float wv = w[(size_t)k * (NMOD * DM)]; a0 += sv[k] * wv; a1 += sv[DM + k] * wv; a2 += sv[2 * DM + k] * wv; }
        part[(kg * 3 + 0) * 128 + n] = a0; part[(kg * 3 + 1) * 128 + n] = a1; part[(kg * 3 + 2) * 128 + n] = a2;
        __syncthreads();
        if (tid < 384) { const int s = tid >> 7; const float v = part[(0 * 3 + s) * 128 + n] + part[(1 * 3 + s) * 128 + n] + part[(2 * 3 + s) * 128 + n] + part[(3 * 3 + s) * 128 + n];
            a->MOD[(size_t)(l * 3 + s) * (NMOD * DM) + n0 + n] = v + a->b_ada[l * NMOD * DM + n0 + n]; }
        __syncthreads();
      } }
    conv_range(a, lds, wave, lane, 0, (gridDim.x == 256) ? CONV_N0 : CONV_NALL, blockIdx.x, gridDim.x);
}

typedef float f32x4v __attribute__((ext_vector_type(4)));
#define ALPHA_DN 1.4142135623730951f
__device__ __forceinline__ unsigned long long pk4(f32x4v v) { return (unsigned long long)pk2(v.x, v.y) | ((unsigned long long)pk2(v.z, v.w) << 32); }

__device__ __forceinline__ void phase_init(KA a, int wave, int lane) {
    const int gw = blockIdx.x * NWAVES + wave, NGW = gridDim.x * NWAVES;
    for (int row = gw; row < NROW; row += NGW) {
        const int s = stream_of_row(row);
        const f32x4v* src = (const f32x4v*)(row < NLAT ? a->x + (size_t)row * DM : a->ctx + (size_t)(row - NLAT) * DM) + lane;
        const f32x4v* sh = (const f32x4v*)(a->MOD + (size_t)(0 * 3 + s) * (NMOD * DM)) + lane; const f32x4v* sc = sh + DM / 4;
        f32x4v* xo = (f32x4v*)(a->X + (size_t)row * DM) + lane; unsigned long long* ho = (unsigned long long*)(a->HB + (size_t)row * DM) + lane;
        f32x4v v[8], t1[8], t2[8];
#pragma unroll
        for (int i = 0; i < 8; ++i) v[i] = __builtin_nontemporal_load(src + 64 * i);
#pragma unroll
        for (int i = 0; i < 8; ++i) t1[i] = sc[64 * i];
#pragma unroll
        for (int i = 0; i < 8; ++i) t2[i] = sh[64 * i];
#pragma unroll
        for (int i = 0; i < 8; ++i) { __builtin_nontemporal_store(v[i], xo + 64 * i); const f32x4v h = v[i] * (t1[i] + 1.f) + t2[i]; ho[64 * i] = pk4(h); }
    }
    for (int i = blockIdx.x * (NWAVES * 64) + wave * 64 + lane; i < SEQ * 64; i += gridDim.x * NWAVES * 64) {
        const int t = i >> 6, f = i & 63; const float inv = powf(10000.f, -(float)(f & 31) / 32.f);
        const float ang = (float)(f < 32 ? (t >> 6) : (t & 63)) * inv;
        a->ROPE[(size_t)t * 128 + f] = cosf(ang); a->ROPE[(size_t)t * 128 + 64 + f] = sinf(ang);
    }
}

__device__ __forceinline__ void phase_ln1(KA a, int l, int nrows, LAS unsigned char* lds, int wave, int lane) {
    const int gw = blockIdx.x * NWAVES + wave, NGW = gridDim.x * NWAVES;
    const f32x4v* gn = (const f32x4v*)(a->ln_gain + (size_t)(l * 2 + 0) * DM) + lane; const f32x4v* bs = (const f32x4v*)(a->ln_bias + (size_t)(l * 2 + 0) * DM) + lane;
    LAS f32x4v* RL = (LAS f32x4v*)lds;
    { const f32x4v* rt = (const f32x4v*)(a->router + (size_t)l * DM * NEXP);
      for (int g = wave * 64 + lane; g < 8192; g += NWAVES * 64) { const int r = g >> 2, c = g & 3, i = r >> 8, q = r & 3, ln = (r >> 2) & 63; RL[((i * 4 + q) * 4 + c) * 64 + ln] = rt[g]; }
      LDS_BAR(); }
    const LAS f32x4v* RLlo = RL + lane; const LAS f32x4v* RLhi = RL + 4096 + lane;
    for (int row = gw; row < nrows; row += NGW) {
        const int s = stream_of_row(row);
        const f32x4v* md = (const f32x4v*)(a->MOD + (size_t)(l * 3 + s) * (NMOD * DM)) + lane;
        f32x4v* xp = (f32x4v*)(a->X + (size_t)row * DM) + lane; const f32x4v* yp = (const f32x4v*)(a->Y + (size_t)row * DM) + lane;
        unsigned long long* ho = (unsigned long long*)(a->HB + (size_t)row * DM) + lane;
        f32x4v v[8], ty[8], tg[8]; float sum = 0.f;
#pragma unroll
        for (int i = 0; i < 8; ++i) v[i] = __builtin_nontemporal_load(xp + 64 * i);
#pragma unroll
        for (int i = 0; i < 8; ++i) ty[i] = __builtin_nontemporal_load(yp + 64 * i);
#pragma unroll
        for (int i = 0; i < 8; ++i) tg[i] = md[2 * (DM / 4) + 64 * i];
#pragma unroll
        for (int i = 0; i < 8; ++i) { v[i] = v[i] * ALPHA_DN + tg[i] * ty[i]; sum += (v[i].x + v[i].y) + (v[i].z + v[i].w); }
        const float mean = wave_sum(sum) * (1.f / DM); float sq = 0.f;
#pragma unroll
        for (int i = 0; i < 8; ++i) { v[i] = v[i] - mean; sq += (v[i].x * v[i].x + v[i].y * v[i].y) + (v[i].z * v[i].z + v[i].w * v[i].w); }
        const float rstd = rsqrtf(wave_sum(sq) * (1.f / DM) + 1e-5f);
        f32x4v h[8];
#pragma unroll
        for (int i = 0; i < 8; ++i) ty[i] = gn[64 * i];
#pragma unroll
        for (int i = 0; i < 8; ++i) tg[i] = bs[64 * i];
#pragma unroll
        for (int i = 0; i < 8; ++i) h[i] = md[4 * (DM / 4) + 64 * i];
#pragma unroll
        for (int i = 0; i < 8; ++i) v[i] = v[i] * rstd * ty[i] + tg[i];
#pragma unroll
        for (int i = 0; i < 8; ++i) ty[i] = md[3 * (DM / 4) + 64 * i];
#pragma unroll
        for (int i = 0; i < 8; ++i) h[i] = v[i] * (h[i] + 1.f) + ty[i];
#pragma unroll
        for (int i = 0; i < 8; ++i) { __builtin_nontemporal_store(v[i], xp + 64 * i); ho[64 * i] = pk4(h[i]); }
        float acc[NEXP];
#pragma unroll
        for (int e = 0; e < NEXP; ++e) acc[e] = 0.f;
#pragma unroll
        for (int i = 0; i < 8; ++i) {
#pragma unroll
            for (int q = 0; q < 4; ++q) { const float hq = h[i][q];
#pragma unroll
                for (int c = 0; c < 4; ++c) { const f32x4v w = (i < 4 ? RLlo : RLhi)[(((i & 3) * 4 + q) * 4 + c) * 64]; acc[c * 4 + 0] += hq * w.x;     acc[c * 4 + 1] += hq * w.y; acc[c * 4 + 2] += hq * w.z; acc[c * 4 + 3] += hq * w.w; } }
            asm volatile("" ::: "memory");
        }
        float m = -1e30f;
#pragma unroll
        for (int e = 0; e < NEXP; ++e) { acc[e] = wave_sum(acc[e]); m = fmaxf(m, acc[e]); }
        float ssum = 0.f;
#pragma unroll
        for (int e = 0; e < NEXP; ++e) { acc[e] = __expf(acc[e] - m); ssum += acc[e]; }
        float mine = 0.f;
#pragma unroll
        for (int e = 0; e < NEXP; ++e) mine = (lane == e) ? acc[e] : mine;
        if (lane < NEXP) { const float af = mine / ssum; a->AFF[(size_t)row * NEXP + lane] = af; a->AFFT[(size_t)lane * NROW + row] = af; }
    }
}

__device__ __forceinline__ void phase_topk(KA a, int layer0, LAS unsigned char* lds, const int tid) {
    const int lane = tid & 63, wave = __builtin_amdgcn_readfirstlane(tid >> 6);
    LAS int* hist = (LAS int*)lds; LAS int* ctl = (LAS int*)(lds + 4096); LAS int* lst = (LAS int*)(lds + 8192); LAS int* eql = (LAS int*)(lds + 16384);
    const int nunits = layer0 ? 544 : 512;
    for (int unit = blockIdx.x; unit < nunits; unit += gridDim.x) {
        int b, e, chunk, T, cap, row0, xs_base;
        if (unit < 512) { b = unit >> 8; e = (unit >> 4) & 15; chunk = unit & 15; T = SEQ; cap = CAP_L; row0 = b * SEQ; xs_base = e * 1024 + b * CAP_L; }
        else { const int u2 = unit - 512; b = u2 >> 4; e = u2 & 15; chunk = 0; T = CTX; cap = CAP_C; row0 = NLAT + b * CTX; xs_base = 16384 + e * 256 + b * CAP_C; }
        unsigned key[8]; unsigned vmask = 0;
        { float tv[8];
#pragma unroll
          for (int q = 0; q < 8; ++q) { const int i = tid + 512 * q; tv[q] = i < T ? a->AFFT[(size_t)e * NROW + row0 + i] : 0.f; }
#pragma unroll
          for (int q = 0; q < 8; ++q) { const int i = tid + 512 * q; const unsigned u = __builtin_bit_cast(unsigned, tv[q]); key[q] = (u & 0x80000000u) ? ~u : (u | 0x80000000u); if (i < T) vmask |= 1u << q; } }
        hist[tid] = 0; hist[tid + 512] = 0;
        LDS_BAR();
        unsigned prefix = 0; int rem = cap;
#pragma unroll
        for (int p = 0; p < 4; ++p) {
            const int sh = 24 - 8 * p;
#pragma unroll
            for (int q = 0; q < 8; ++q) { const int d = (int)((key[q] >> sh) & 255u);
                if (p == 0) {
                    const bool act = (vmask >> q) & 1u; unsigned long long m = __ballot(act);
                    while (m) { const int l0 = __builtin_ctzll(m); const int d0 = __shfl(d, l0); const unsigned long long same = __ballot(act && d == d0);
                        if (lane == l0) __hip_atomic_fetch_add(hist + d0, (int)__builtin_popcountll(same), __ATOMIC_RELAXED, __HIP_MEMORY_SCOPE_WORKGROUP); m &= ~same; }
                } else { const bool act = ((vmask >> q) & 1u) && ((key[q] >> (sh + 8)) == (prefix >> (sh + 8)));
                    if (act) __hip_atomic_fetch_add(hist + p * 256 + d, 1, __ATOMIC_RELAXED, __HIP_MEMORY_SCOPE_WORKGROUP); } }
            LDS_BAR();
            if (wave == 0) {
                const int h0 = hist[p * 256 + 4 * lane], h1 = hist[p * 256 + 4 * lane + 1], h2 = hist[p * 256 + 4 * lane + 2], h3 = hist[p * 256 + 4 * lane + 3];
                const int tot = h0 + h1 + h2 + h3; int suf = tot;
#pragma unroll
                for (int off = 1; off < 64; off <<= 1) { const int o = __shfl_down(suf, off); if (lane + off < 64) suf += o; }
                const int G3 = suf - tot, G2 = G3 + h3, G1 = G2 + h2, G0 = G1 + h1;
                int found = -1, g = 0;
                if (G3 < rem && rem <= G3 + h3) { found = 3; g = G3; } else if (G2 < rem && rem <= G2 + h2) { found = 2; g = G2; }
                else if (G1 < rem && rem <= G1 + h1) { found = 1; g = G1; } else if (G0 < rem && rem <= G0 + h0) { found = 0; g = G0; }
                if (found >= 0) { ctl[0] = 4 * lane + found; ctl[1] = rem - g; } }
            LDS_BAR();
            prefix |= (unsigned)ctl[0] << sh; rem = ctl[1];
        }
        unsigned gtm = 0, eqm = 0; int we = 0;
#pragma unroll
        for (int q = 0; q < 8; ++q) { const bool v = (vmask >> q) & 1u; if (v && key[q] > prefix) gtm |= 1u << q; const bool eq = v && key[q] == prefix; if (eq) eqm |= 1u << q; we += (int)__builtin_popcountll(__ballot(eq)); }
        if (lane == 0) ctl[24 + wave] = we;
        if (tid == 0) ctl[2] = 0;
        LDS_BAR();
        int E = 0;
#pragma unroll
        for (int w = 0; w < NWAVES; ++w) E += ctl[24 + w];
        unsigned selm = gtm | eqm;
        if (E != rem) {
#pragma unroll
            for (int q = 0; q < 8; ++q) if ((eqm >> q) & 1u) { const int pos = __hip_atomic_fetch_add(ctl + 2, 1, __ATOMIC_RELAXED, __HIP_MEMORY_SCOPE_WORKGROUP); eql[pos] = tid + 512 * q; }
            LDS_BAR();
            selm = gtm;
#pragma unroll 1
            for (int q = 0; q < 8; ++q) if ((eqm >> q) & 1u) { const int i = tid + 512 * q; int c = 0; for (int j = 0; j < E; ++j) c += (eql[j] < i) ? 1 : 0; if (c < rem) selm |= 1u << q; }
        }
        const int c0 = chunk * 256, qs = chunk >> 1; const bool mychunk = (tid >> 8) == (chunk & 1);
        int wb = 0; bool sq = false;
#pragma unroll
        for (int q = 0; q < 8; ++q) { const bool sl = (selm >> q) & 1u; wb += (int)__builtin_popcountll(__ballot(sl && (tid + 512 * q) < c0)); if (q == qs) sq = sl; }
        const unsigned long long cm = __ballot(mychunk && sq);
        if (lane == 0) { ctl[8 + wave] = wb; ctl[16 + wave] = (int)__builtin_popcountll(cm); }
        LDS_BAR();
        int before = 0, woff = 0, n = 0;
#pragma unroll
        for (int w = 0; w < NWAVES; ++w) { before += ctl[8 + w]; const int c = ctl[16 + w]; if (w < wave) woff += c; n += c; }
        if (mychunk) { const int t = c0 + (tid & 255); const int pin = (int)__builtin_popcountll(cm & ((1ull << lane) - 1ull)); const int pos = before + woff + pin;
            a->SEL[(size_t)(row0 + t) * NEXP + e] = sq ? xs_base + pos : -1;
            if (sq) lst[woff + pin] = t | (pos << 16); }
        LDS_BAR();
        for (int idx0 = wave; idx0 < n; idx0 += 4 * NWAVES) { v4u tb[4][4]; int xr[4];
#pragma unroll
            for (int j = 0; j < 4; ++j) { const int idx = idx0 + j * NWAVES; xr[j] = -1;
                if (idx < n) { const int pr = lst[idx], tt = pr & 0xffff; xr[j] = xs_base + (pr >> 16); const v4u* src = (const v4u*)(a->HB + (size_t)(row0 + tt) * DM) + lane;
                    tb[j][0] = src[0]; tb[j][1] = src[64]; tb[j][2] = src[128]; tb[j][3] = src[192]; } }
#pragma unroll
            for (int j = 0; j < 4; ++j) if (xr[j] >= 0) { v4u* dst = (v4u*)(a->XS + (size_t)xr[j] * DM) + lane; dst[0] = tb[j][0]; dst[64] = tb[j][1]; dst[128] = tb[j][2]; dst[192] = tb[j][3]; } }
        LDS_BAR();
    }
}

__device__ __forceinline__ void phase_ln2(KA a, int l, int nrows, int wave, int lane) {
    const int gw = blockIdx.x * NWAVES + wave, NGW = gridDim.x * NWAVES; const bool last = (l == 1);
    const f32x4v* gn = (const f32x4v*)(a->ln_gain + (size_t)(l * 2 + 1) * DM) + 2 * lane; const f32x4v* bs = (const f32x4v*)(a->ln_bias + (size_t)(l * 2 + 1) * DM) + 2 * lane;
    for (int row = gw; row < nrows; row += NGW) {
        const int s = stream_of_row(row);
        f32x4v f[8];
#pragma unroll
        for (int i = 0; i < 8; ++i) f[i] = (f32x4v){0.f, 0.f, 0.f, 0.f};
        const f32x4v* md = (const f32x4v*)(a->MOD + (size_t)(l * 3 + s) * (NMOD * DM)) + 2 * lane;
        f32x4v* xp = (f32x4v*)(a->X + (size_t)row * DM) + 2 * lane;
        int myxr = -1; float myg = 0.f;
        if (lane < NEXP) { myxr = a->SEL[(size_t)row * NEXP + lane]; myg = a->AFF[(size_t)row * NEXP + lane]; }
        f32x4v xv[8], m5[8];
#pragma unroll
        for (int i = 0; i < 8; ++i) { const int o = 128 * (i >> 1) + (i & 1); xv[i] = __builtin_nontemporal_load(xp + o); m5[i] = md[5 * (DM / 4) + o]; }
        unsigned long long mask = __ballot(myxr >= 0);
#define ACC8(W, G, I) do { f[2 * I].x += G * __builtin_bit_cast(float, W.x << 16); f[2 * I].y += G * __builtin_bit_cast(float, W.x & 0xffff0000u); \
            f[2 * I].z += G * __builtin_bit_cast(float, W.y << 16); f[2 * I].w += G * __builtin_bit_cast(float, W.y & 0xffff0000u); \
            f[2 * I + 1].x += G * __builtin_bit_cast(float, W.z << 16); f[2 * I + 1].y += G * __builtin_bit_cast(float, W.z & 0xffff0000u); \
            f[2 * I + 1].z += G * __builtin_bit_cast(float, W.w << 16); f[2 * I + 1].w += G * __builtin_bit_cast(float, W.w & 0xffff0000u); } while (0)
        while (mask) {
            const int e0 = __builtin_ctzll(mask); mask &= mask - 1; const bool two = mask != 0ull; const int e1 = two ? __builtin_ctzll(mask) : e0; if (two) mask &= mask - 1;
            const int xr0 = __shfl(myxr, e0), xr1 = __shfl(myxr, e1); const float g0 = __shfl(myg, e0), g1 = two ? __shfl(myg, e1) : 0.f;
            const v4u* y0 = (const v4u*)(a->YE + (size_t)xr0 * DM) + lane; const v4u* y1 = (const v4u*)(a->YE + (size_t)xr1 * DM) + lane;
            v4u w0[4], w1[4];
#pragma unroll
            for (int i = 0; i < 4; ++i) { w0[i] = __builtin_nontemporal_load(y0 + 64 * i); w1[i] = __builtin_nontemporal_load(y1 + 64 * i); }
#pragma unroll
            for (int i = 0; i < 4; ++i) { ACC8(w0[i], g0, i); ACC8(w1[i], g1, i); }
        }
#undef ACC8
        float sum = 0.f;
#pragma unroll
        for (int i = 0; i < 8; ++i) { f[i] = xv[i] * ALPHA_DN + m5[i] * f[i]; sum += (f[i].x + f[i].y) + (f[i].z + f[i].w); }
        const float mean = wave_sum(sum) * (1.f / DM); float sq = 0.f;
#pragma unroll
        for (int i = 0; i < 8; ++i) { f[i] = f[i] - mean; sq += (f[i].x * f[i].x + f[i].y * f[i].y) + (f[i].z * f[i].z + f[i].w * f[i].w); }
        const float rstd = rsqrtf(wave_sum(sq) * (1.f / DM) + 1e-5f);
        const f32x4v* mdn = (const f32x4v*)(a->MOD + (size_t)((last ? 0 : (l + 1)) * 3 + s) * (NMOD * DM)) + 2 * lane;
        f32x4v* op = (f32x4v*)(a->out + (size_t)row * DM) + 2 * lane; v4u* ho = (v4u*)(a->HB + (size_t)row * DM) + lane;
#pragma unroll
        for (int i = 0; i < 8; ++i) { const int o = 128 * (i >> 1) + (i & 1); xv[i] = gn[o]; }
#pragma unroll
        for (int i = 0; i < 8; ++i) { const int o = 128 * (i >> 1) + (i & 1); m5[i] = bs[o]; }
#pragma unroll
        for (int i = 0; i < 8; ++i) f[i] = f[i] * rstd * xv[i] + m5[i];
        if (last) {
#pragma unroll
            for (int i = 0; i < 8; ++i) { const int o = 128 * (i >> 1) + (i & 1); __builtin_nontemporal_store(f[i], op + o); }
        } else {
            v4u hw[4];
#pragma unroll
            for (int i = 0; i < 8; ++i) { const int o = 128 * (i >> 1) + (i & 1); xv[i] = mdn[1 * (DM / 4) + o]; }
#pragma unroll
            for (int i = 0; i < 8; ++i) { const int o = 128 * (i >> 1) + (i & 1); m5[i] = mdn[o]; }
#pragma unroll
            for (int i = 0; i < 4; ++i) {
                const f32x4v h0 = f[2 * i] * (xv[2 * i] + 1.f) + m5[2 * i], h1 = f[2 * i + 1] * (xv[2 * i + 1] + 1.f) + m5[2 * i + 1];
                hw[i].x = pk2(h0.x, h0.y); hw[i].y = pk2(h0.z, h0.w); hw[i].z = pk2(h1.x, h1.y); hw[i].w = pk2(h1.z, h1.w); }
#pragma unroll
            for (int i = 0; i < 8; ++i) { const int o = 128 * (i >> 1) + (i & 1); __builtin_nontemporal_store(f[i], xp + o); }
#pragma unroll
            for (int i = 0; i < 4; ++i) ho[64 * i] = hw[i];
        }
    }
}

namespace att {
using bf16 = unsigned short;
constexpr int   D = 128, NW = 8, QBLK = 32, KVBLK = 64;
constexpr float SCALE = 0.088388347648318440f;
constexpr float THR = 8.f;
constexpr int SDEPTH = 1;
constexpr int LDQ = 1024, LDK = 256, LDO = 2048;
constexpr size_t SHM_V = KVBLK * D * 2, SHM_K = KVBLK * D * 2, SHM_ATTN = 2 * SHM_V + 2 * SHM_K + NW * 64 * 4;
using bf16x8 = __attribute__((ext_vector_type(8))) short;
using s16x4  = __attribute__((ext_vector_type(4))) short;
using f32x16 = __attribute__((ext_vector_type(16))) float;
using f32x8  = __attribute__((ext_vector_type(8))) float;
using u32x4  = __attribute__((ext_vector_type(4))) unsigned;
#define KSWZ(row, colB) ((row) * 256 + ((colB) ^ (((row) & 7) << 4)))
#define SBAR() __builtin_amdgcn_sched_barrier(0)
__device__ __forceinline__ int crow(int r, int hi) { return (r & 3) + 8 * (r >> 2) + 4 * hi; }
__device__ __forceinline__ unsigned cvtpk(float lo, float hi) {
  unsigned r; asm volatile("v_cvt_pk_bf16_f32 %0, %1, %2" : "=v"(r) : "v"(lo), "v"(hi)); return r;
}
template <typename TIn> struct Stage;
template <> struct Stage<bf16>  { using T = bf16x8;
  __device__ static __forceinline__ T ld8(const bf16* p) { return *reinterpret_cast<const bf16x8*>(p); }
  __device__ static __forceinline__ bf16x8 tobf(T x) { return x; } };
template <> struct Stage<float> { using T = f32x8;
  __device__ static __forceinline__ T ld8(const float* p) { return *reinterpret_cast<const f32x8*>(p); }
  __device__ static __forceinline__ bf16x8 tobf(T x) {
    u32x4 w = {cvtpk(x[0], x[1]), cvtpk(x[2], x[3]), cvtpk(x[4], x[5]), cvtpk(x[6], x[7])}; return *reinterpret_cast<bf16x8*>(&w); } };

__device__ __forceinline__ void partialSM(f32x16& p0, f32x16& p1, float& m_reg, float& mn, float& alpha) {
  constexpr float C = SCALE * 1.4426950408889634f;
  float pmax = p0[0]; for (int r = 1; r < 16; ++r) pmax = fmaxf(pmax, p0[r]); for (int r = 0; r < 16; ++r) pmax = fmaxf(pmax, p1[r]);
  { auto rr = __builtin_amdgcn_permlane32_swap(__float_as_uint(pmax), __float_as_uint(pmax), false, false);
    pmax = fmaxf(__uint_as_float(rr[0]), __uint_as_float(rr[1])); }
  if (__builtin_expect(__all(pmax - m_reg <= THR / SCALE), 1)) { mn = m_reg; alpha = 1.f; }
  else { mn = fmaxf(m_reg, pmax); alpha = __builtin_amdgcn_exp2f((m_reg - mn) * C); m_reg = mn; }
  float mnC = -mn * C;
  for (int r = 0; r < 16; ++r) p0[r] = fmaf(p0[r], C, mnC); for (int r = 0; r < 16; ++r) p1[r] = fmaf(p1[r], C, mnC);
  for (int r = 0; r < 16; ++r) p0[r] = __builtin_amdgcn_exp2f(p0[r]);
}
__device__ __forceinline__ void finishSM(f32x16& p0, f32x16& p1, float alpha, float& l_reg, bf16x8& pa0, bf16x8& pa1, bf16x8& pa2, bf16x8& pa3) {
  for (int r = 0; r < 16; ++r) p1[r] = __builtin_amdgcn_exp2f(p1[r]);
  float ps = 0; for (int r = 0; r < 16; ++r) ps += p0[r]; for (int r = 0; r < 16; ++r) ps += p1[r];
  { auto rr = __builtin_amdgcn_permlane32_swap(__float_as_uint(ps), __float_as_uint(ps), false, false);
    ps = __uint_as_float(rr[0]) + __uint_as_float(rr[1]); }
  l_reg = l_reg * alpha + ps;
#define PK4(P, BASE, OUT) do { unsigned a0 = cvtpk(P[BASE + 0], P[BASE + 1]), a1 = cvtpk(P[BASE + 2], P[BASE + 3]);   \
    unsigned b0 = cvtpk(P[BASE + 4], P[BASE + 5]), b1 = cvtpk(P[BASE + 6], P[BASE + 7]);                              \
    auto r0 = __builtin_amdgcn_permlane32_swap(a0, b0, false, false); auto r1 = __builtin_amdgcn_permlane32_swap(a1, b1, false, false); \
    u32x4 w = {r0[0], r1[0], r0[1], r1[1]}; OUT = *reinterpret_cast<bf16x8*>(&w); } while (0)
  PK4(p0, 0, pa0); PK4(p0, 8, pa1); PK4(p1, 0, pa2); PK4(p1, 8, pa3);
#undef PK4
}
__device__ __forceinline__ void qkt(f32x16& p0, f32x16& p1, const bf16* Ks, const bf16x8* qr, int r32, int hi) {
  p0 = f32x16{}; p1 = f32x16{};
  for (int d0 = 0; d0 < 8; ++d0) { int cb = (d0 * 16 + hi * 8) * 2;
    bf16x8 b0 = *reinterpret_cast<const bf16x8*>((const char*)Ks + KSWZ(r32, cb));
    bf16x8 b1 = *reinterpret_cast<const bf16x8*>((const char*)Ks + KSWZ(32 + r32, cb));
    p0 = __builtin_amdgcn_mfma_f32_32x32x16_bf16(b0, qr[d0], p0, 0, 0, 0);
    p1 = __builtin_amdgcn_mfma_f32_32x32x16_bf16(b1, qr[d0], p1, 0, 0, 0); }
}
__device__ __forceinline__ int v_st(int k, int c) { const int kk = (k & ~0xC) | ((k & 4) << 1) | ((k & 8) >> 1); return ((kk >> 3) * 4 + (c >> 5)) * 512 + ((kk & 7) * 32 + (c & 31)) * 2; }
__device__ __forceinline__ int v_rd_base(int lane) { return ((lane & 3) << 3) | (((lane >> 2) & 3) << 6) | (((lane >> 4) & 1) << 5) | (((lane >> 5) & 1) << 8); }
constexpr int v_rd_off(int d0, int ks, int half) { return d0 * 512 + ks * 4096 + half * 2048; }
template <int OFF> __device__ __forceinline__ s16x4 tr_read(int vb) {
  s16x4 r; asm volatile("ds_read_b64_tr_b16 %0, %1 offset:%2" : "=&v"(r) : "v"(vb), "i"(OFF) : "memory"); return r;
}
template <int D0> __device__ __forceinline__ void pv_one(f32x16& od, int vb, bf16x8 pa0, bf16x8 pa1, bf16x8 pa2, bf16x8 pa3) {
  const s16x4 l0 = tr_read<v_rd_off(D0, 0, 0)>(vb), h0 = tr_read<v_rd_off(D0, 0, 1)>(vb), l1 = tr_read<v_rd_off(D0, 1, 0)>(vb), h1 = tr_read<v_rd_off(D0, 1, 1)>(vb);
  const s16x4 l2 = tr_read<v_rd_off(D0, 2, 0)>(vb), h2 = tr_read<v_rd_off(D0, 2, 1)>(vb), l3 = tr_read<v_rd_off(D0, 3, 0)>(vb), h3 = tr_read<v_rd_off(D0, 3, 1)>(vb);
  asm volatile("s_waitcnt lgkmcnt(0)" ::: "memory"); SBAR();
#define PK(L, H) (bf16x8){L[0], L[1], L[2], L[3], H[0], H[1], H[2], H[3]}
  od = __builtin_amdgcn_mfma_f32_32x32x16_bf16(pa0, PK(l0, h0), od, 0, 0, 0);
  od = __builtin_amdgcn_mfma_f32_32x32x16_bf16(pa1, PK(l1, h1), od, 0, 0, 0);
  od = __builtin_amdgcn_mfma_f32_32x32x16_bf16(pa2, PK(l2, h2), od, 0, 0, 0);
  od = __builtin_amdgcn_mfma_f32_32x32x16_bf16(pa3, PK(l3, h3), od, 0, 0, 0);
#undef PK
}
__device__ __forceinline__ void pv_d0(f32x16* o, int vb, bf16x8 pa0, bf16x8 pa1, bf16x8 pa2, bf16x8 pa3) {
  pv_one<0>(o[0], vb, pa0, pa1, pa2, pa3); pv_one<1>(o[1], vb, pa0, pa1, pa2, pa3); pv_one<2>(o[2], vb, pa0, pa1, pa2, pa3); pv_one<3>(o[3], vb, pa0, pa1, pa2, pa3);
}

template <typename TQ>
__device__ __forceinline__ void attn_dense_body(const TQ* __restrict__ Qb, const bf16* __restrict__ Kh, const bf16* __restrict__ Vh,
                                                unsigned short* __restrict__ Ob, int seq, char* lds) {
  using St = Stage<bf16>; using SQ = Stage<TQ>;
  int tid_ = threadIdx.x; asm volatile("" : "+v"(tid_));
  const int tid = tid_, wid = tid >> 6, lane = tid & 63, r32 = lane & 31, hi = lane >> 5;
  bf16* V_lds = (bf16*)lds; bf16* K_lds = (bf16*)(lds + 2 * SHM_V);
  float* ws = (float*)(lds + 2 * SHM_V + 2 * SHM_K) + wid * 64; float* li_l = ws; float* al_l = ws + 32;
  float m_reg = -1e30f, l_reg = 0; f32x16 o[4] = {}; bf16x8 qr[8];
  const TQ* Qw = Qb + (long)(wid * QBLK + r32) * LDQ + hi * 8;
#pragma unroll
  for (int d0 = 0; d0 < 8; ++d0) qr[d0] = SQ::tobf(SQ::ld8(Qw + d0 * 16));
  const int sr = tid >> 4, sc = (tid & 15) * 8, vst0 = v_st(sr, sc), vst1 = v_st(32 + sr, sc);
  const int vb0 = (int)(uintptr_t)V_lds + v_rd_base(lane);
  struct { typename St::T vs0, vs1, ks0, ks1; } sr_[SDEPTH];
#define SLOAD(i, k0) do { sr_[i].vs0 = St::ld8(&Vh[(long)((k0) + sr) * LDK + sc]); sr_[i].vs1 = St::ld8(&Vh[(long)((k0) + 32 + sr) * LDK + sc]); \
    sr_[i].ks0 = St::ld8(&Kh[(long)((k0) + sr) * LDK + sc]); sr_[i].ks1 = St::ld8(&Kh[(long)((k0) + 32 + sr) * LDK + sc]); } while (0)
#define SWRITE(b, i) do { *(bf16x8*)((char*)V_lds + (b) * SHM_V + vst0) = St::tobf(sr_[i].vs0);          \
    *(bf16x8*)((char*)V_lds + (b) * SHM_V + vst1) = St::tobf(sr_[i].vs1); int kc = sc * 2;               \
    *(bf16x8*)((char*)K_lds + (b) * SHM_K + KSWZ(sr, kc)) = St::tobf(sr_[i].ks0);                       \
    *(bf16x8*)((char*)K_lds + (b) * SHM_K + KSWZ(32 + sr, kc)) = St::tobf(sr_[i].ks1); } while (0)
#define SWAIT() do { if constexpr (SDEPTH == 2) asm volatile("s_waitcnt vmcnt(4)" ::: "memory"); else asm volatile("s_waitcnt vmcnt(0)" ::: "memory"); } while (0)
#define RESC(a) do { if (__any((a) < 1.f)) { if (hi == 0) al_l[r32] = (a); asm volatile("s_waitcnt lgkmcnt(0)" ::: "memory"); \
    for (int d = 0; d < 4; ++d) for (int r = 0; r < 16; ++r) o[d][r] *= al_l[crow(r, hi)]; } } while (0)
  f32x16 pA0, pA1, pB0, pB1; float mnA, mnB, alA, alB; bf16x8 pa0, pa1, pa2, pa3; const int NT = seq / KVBLK;
  constexpr int SE = 0, SO = SDEPTH - 1;
  SLOAD(SE, 0); asm volatile("s_waitcnt vmcnt(0)" ::: "memory"); SWRITE(0, SE); __syncthreads();
  qkt(pA0, pA1, K_lds, qr, r32, hi); partialSM(pA0, pA1, m_reg, mnA, alA);
  SLOAD(SO, KVBLK); if constexpr (SDEPTH == 2) { if (2 < NT) SLOAD(SE, 2 * KVBLK); }
  SWAIT(); SWRITE(1, SO); __syncthreads();
  for (int j = 1; j + 1 < NT; j += 2) {
    SBAR(); qkt(pB0, pB1, (bf16*)((char*)K_lds + SHM_K), qr, r32, hi);
    finishSM(pA0, pA1, alA, l_reg, pa0, pa1, pa2, pa3); SBAR();
    SLOAD(SO, (j + SDEPTH) * KVBLK); SBAR();
    pv_d0(o, vb0, pa0, pa1, pa2, pa3); partialSM(pB0, pB1, m_reg, mnB, alB);
    __syncthreads(); SWAIT(); SWRITE(0, SE);
    RESC(alB); __syncthreads();
    SBAR(); qkt(pA0, pA1, K_lds, qr, r32, hi);
    finishSM(pB0, pB1, alB, l_reg, pa0, pa1, pa2, pa3); SBAR();
    if (SDEPTH == 1 || j + 3 < NT) SLOAD(SE, (j + 1 + SDEPTH) * KVBLK); SBAR();
    pv_d0(o, vb0 + (int)SHM_V, pa0, pa1, pa2, pa3); partialSM(pA0, pA1, m_reg, mnA, alA);
    __syncthreads(); SWAIT(); SWRITE(1, SO);
    RESC(alA); __syncthreads();
  }
  SBAR(); qkt(pB0, pB1, (bf16*)((char*)K_lds + SHM_K), qr, r32, hi);
  finishSM(pA0, pA1, alA, l_reg, pa0, pa1, pa2, pa3); SBAR();
  pv_d0(o, vb0, pa0, pa1, pa2, pa3); partialSM(pB0, pB1, m_reg, mnB, alB);
  __syncthreads(); RESC(alB);
  finishSM(pB0, pB1, alB, l_reg, pa0, pa1, pa2, pa3); SBAR();
  pv_d0(o, vb0 + (int)SHM_V, pa0, pa1, pa2, pa3);
  if (hi == 0) li_l[r32] = l_reg; asm volatile("s_waitcnt lgkmcnt(0)" ::: "memory");
  float rli[16];
#pragma unroll
  for (int r = 0; r < 16; ++r) rli[r] = __builtin_amdgcn_rcpf(li_l[crow(r, hi)]);
  unsigned short* Ow = Ob + (long)(wid * QBLK) * LDO;
#pragma unroll
  for (int r = 0; r < 16; ++r) { int orow = crow(r, hi);
    for (int d0 = 0; d0 < 4; ++d0) Ow[(long)orow * LDO + d0 * 32 + r32] = (unsigned short)f2bf(o[d0][r] * rli[r]); }
#undef SLOAD
#undef SWRITE
#undef SWAIT
#undef RESC
}

}
#define PC_GLA_Q 0
#define PC_GLA_K 256
#define PC_GLA_V 512
#define PC_GLA_G 1024
#define PC_GDN 1536
#define PC_GDN_Z 3072
#define PC_ATT_Q 3584
#define PC_ATT_K 4608
#define PC_ATT_V 4864
#define NKEY (CTX + SEQ)
__device__ __forceinline__ float bflo(unsigned w) { return __builtin_bit_cast(float, w << 16); }
__device__ __forceinline__ float bfhi(unsigned w) { return __builtin_bit_cast(float, w & 0xffff0000u); }
__device__ __forceinline__ float row16_sum(float v) {
#define R16_DPP(CTRL) __builtin_bit_cast(float, __builtin_amdgcn_update_dpp(0, __builtin_bit_cast(int, v), CTRL, 0xF, 0xF, false))
  v += R16_DPP(0xB1); v += R16_DPP(0x4E); v += R16_DPP(0x141); v += R16_DPP(0x140);
#undef R16_DPP
  return v;
}
__device__ __forceinline__ void phase_prep(KA a, int l, LAS unsigned char* lds, int wave, int lane) {
    LAS float* CW = (LAS float*)lds; LAS float* RT = (LAS float*)(lds + 32768);
    { const int tid = wave * 64 + lane;
      for (int i = tid; i < 5 * 1536 / 4; i += NWAVES * 64) ((LAS f32x4v*)CW)[i] = ((const f32x4v*)(a->gdn_conv + (size_t)l * 5 * 1536))[i];
      for (int i = tid; i < 2 * 64 * 16; i += NWAVES * 64) { const int axis = i >> 10, pos = (i >> 4) & 63, c4 = i & 15;
          const float* src = axis == 0 ? a->ROPE + (size_t)(pos * 64) * 128 + (c4 < 8 ? 4 * c4 : 64 + 4 * (c4 - 8)) : a->ROPE + (size_t)pos * 128 + (c4 < 8 ? 32 + 4 * c4 : 96 + 4 * (c4 - 8));
          ((LAS f32x4v*)RT)[i] = *(const f32x4v*)src; }
      LDS_BAR(); }
    const int gw = blockIdx.x * NWAVES + wave, NGW = gridDim.x * NWAVES;
    const int hs = lane >> 4, e0 = 8 * (lane & 15);
    const int axis = (lane & 15) >> 3, ph = (lane >> 2) & 1, f0 = 8 * (lane & 3);
    f32x4v gq0, gq1, gk0, gk1;
    { const float* gp = a->attn_qk_norm + (size_t)l * 256; gq0 = *(const f32x4v*)(gp + e0); gq1 = *(const f32x4v*)(gp + e0 + 4); gk0 = *(const f32x4v*)(gp + 128 + e0); gk1 = *(const f32x4v*)(gp + 128 + e0 + 4); }
    for (int g = gw; g < NROW / 4; g += NGW) {
        const int row0 = 4 * g;
#pragma unroll 1
        for (int rh = 0; rh < 4; rh += 2) { v4u w[2][3];
#pragma unroll
          for (int rr = 0; rr < 2; ++rr)
#pragma unroll
              for (int j = 0; j < 3; ++j) w[rr][j] = *(const v4u*)(a->P + (size_t)(row0 + rh + rr) * PW + PC_ATT_Q + j * 512 + lane * 8);
#pragma unroll
          for (int rr = 0; rr < 2; ++rr) { const int row = row0 + rh + rr; const bool lat = row < NLAT; const int t = row & (SEQ - 1);
              f32x4v c0 = {1.f, 1.f, 1.f, 1.f}, c1 = c0, s0 = {0.f, 0.f, 0.f, 0.f}, s1 = s0;
              if (lat) { const LAS f32x4v* rp = (const LAS f32x4v*)(RT + ((axis * 64 + (axis ? (t & 63) : (t >> 6))) * 64)) + (f0 >> 2); c0 = rp[0]; c1 = rp[1]; s0 = rp[8]; s1 = rp[9]; }
#pragma unroll
              for (int j = 0; j < 3; ++j) { const v4u ww = w[rr][j]; const bool isv = (j == 2) && lane >= 32; v4u ow = ww;
                  if (!isv) { float x[8] = {bflo(ww.x), bfhi(ww.x), bflo(ww.y), bfhi(ww.y), bflo(ww.z), bfhi(ww.z), bflo(ww.w), bfhi(ww.w)};
                      float ss = 0.f;
#pragma unroll
                      for (int q = 0; q < 8; ++q) ss += x[q] * x[q];
                      const float sc = rsqrtf(row16_sum(ss) * (1.f / 128.f) + 1e-6f);
                      const f32x4v g0 = (j == 2) ? gk0 : gq0, g1 = (j == 2) ? gk1 : gq1;
#pragma unroll
                      for (int q = 0; q < 4; ++q) { x[q] = x[q] * sc * g0[q]; x[4 + q] = x[4 + q] * sc * g1[q]; }
                      if (lat) {
#pragma unroll
                          for (int q = 0; q < 8; ++q) { const float pq = __shfl_xor(x[q], 4); const float cq = q < 4 ? c0[q] : c1[q - 4], sq = q < 4 ? s0[q] : s1[q - 4];
                              x[q] = ph == 0 ? x[q] * cq - pq * sq : x[q] * cq + pq * sq; } }
                      ow = (v4u){pk2(x[0], x[1]), pk2(x[2], x[3]), pk2(x[4], x[5]), pk2(x[6], x[7])}; }
                  if (j < 2) *(v4u*)(a->QB + (size_t)row * 1024 + j * 512 + lane * 8) = ow;
                  else { const int b = lat ? row >> 12 : (row - NLAT) >> 8, jk = lat ? CTX + t : (row - NLAT) & (CTX - 1);
                      *(v4u*)((lane < 32 ? a->KB : a->VB) + (size_t)(b * NKEY + jk) * 256 + (lane & 31) * 8) = ow; } } } }
        { int start, len; if (row0 < NLAT) { start = row0 & ~(SEQ - 1); len = SEQ; } else { start = NLAT + ((row0 - NLAT) & ~(CTX - 1)); len = CTX; }
#pragma unroll 1
          for (int j = 0; j < 3; ++j) { v4u w8[8];
#pragma unroll
              for (int i = 0; i < 8; ++i) { const int r = row0 - 2 + i; w8[i] = (r >= start && r < start + len) ? *(const v4u*)(a->P + (size_t)r * PW + PC_GDN + j * 512 + lane * 8) : (v4u){0u, 0u, 0u, 0u}; }
              f32x4v cw[5][2];
#pragma unroll
              for (int tp = 0; tp < 5; ++tp) { const LAS f32x4v* cp = (const LAS f32x4v*)(CW + tp * 1536 + j * 512 + lane * 8); cw[tp][0] = cp[0]; cw[tp][1] = cp[1]; }
#pragma unroll
              for (int rr = 0; rr < 4; ++rr) { float y[8] = {0.f, 0.f, 0.f, 0.f, 0.f, 0.f, 0.f, 0.f};
#pragma unroll
                  for (int tp = 0; tp < 5; ++tp) { const v4u ww = w8[rr + tp];
                      y[0] += bflo(ww.x) * cw[tp][0].x; y[1] += bfhi(ww.x) * cw[tp][0].y; y[2] += bflo(ww.y) * cw[tp][0].z; y[3] += bfhi(ww.y) * cw[tp][0].w;
                      y[4] += bflo(ww.z) * cw[tp][1].x; y[5] += bfhi(ww.z) * cw[tp][1].y; y[6] += bflo(ww.w) * cw[tp][1].z; y[7] += bfhi(ww.w) * cw[tp][1].w; }
                  float ss = 0.f;
#pragma unroll
                  for (int q = 0; q < 8; ++q) { y[q] = silu_f(y[q]); ss += y[q] * y[q]; }
                  if (j < 2) { float sc = rsqrtf(row16_sum(ss) + 1e-6f); if (j == 0) sc *= 0.08838834764831845f;
#pragma unroll
                      for (int q = 0; q < 8; ++q) y[q] *= sc; }
                  *(v4u*)(a->GQKV + (size_t)(row0 + rr) * 1536 + j * 512 + lane * 8) = (v4u){pk2(y[0], y[1]), pk2(y[2], y[3]), pk2(y[4], y[5]), pk2(y[6], y[7])}; } } }
        if (lane < 32) { const int row = row0 + (lane >> 3), idx = lane & 7, z = idx >> 2, h = idx & 3;
            const float pb = a->PG[(size_t)row * 64 + 32 + idx], pa = a->PG[(size_t)row * 64 + 40 + idx];
            a->BETA[((size_t)z * NROW + row) * 4 + h] = sigmoid_f(pb);
            a->GG[((size_t)z * NROW + row) * 4 + h] = -__expf(a->gdn_a_log[l * 8 + idx]) * softplus_f(pa + a->gdn_dt_bias[l * 8 + idx]); }
    }
}
typedef short bf16x8v __attribute__((ext_vector_type(8)));
typedef float f32x16v __attribute__((ext_vector_type(16)));
#define MFMA32(A_, B_, C_) __builtin_amdgcn_mfma_f32_32x32x16_bf16(A_, B_, C_, 0, 0, 0)
__device__ __forceinline__ int crow_(int r, int hi) { return (r & 3) + 8 * (r >> 2) + 4 * hi; }
__device__ __forceinline__ bf16x8v fragL(const LAS unsigned char* base, int pitchB, int row, int k) { return *(const LAS bf16x8v*)(base + row * pitchB + k * 2); }
__device__ __forceinline__ bf16x8v fragG(const bf16_t* base, int ld, int row, int k) { return *(const bf16x8v*)(base + (size_t)row * ld + k); }
__device__ __forceinline__ int chunk_row(int b, int dir, int n, int i) {
    if (n < 4) { const int p = 64 * n + i; return NLAT + b * CTX + (dir ? CTX - 1 - p : p); }
    const int p = 64 * (n - 4) + i; return b * SEQ + (dir ? SEQ - 1 - p : p);
}
#define NCH 68
#define P144 144
#define P272 272
__device__ __forceinline__ void gla_stage_w(KA a, int l, int z, int h, LAS float* WL, int tid) {
    if (tid < 256) { const int j = tid >> 4, c4 = tid & 15; *(LAS f32x4v*)(WL + j * 64 + 4 * c4) = *(const f32x4v*)(a->gla_w_up + ((size_t)(l * 2 + z) * 16 + j) * 256 + h * 64 + 4 * c4); }
    else if (tid < 272) { const int c4 = tid - 256; *(LAS f32x4v*)(WL + 1024 + 4 * c4) = *(const f32x4v*)(a->gla_b_up + (size_t)(l * 2 + z) * 256 + h * 64 + 4 * c4); }
}
__device__ __forceinline__ void gla_loga8(KA a, const LAS float* WL, int z, int row, int k8, float (&la)[8]) {
    const f32x4v* rp = (const f32x4v*)(a->PG + (size_t)row * 64 + z * 16);
    const f32x4v r0 = rp[0], r1 = rp[1], r2 = rp[2], r3 = rp[3]; const float rj[16] = {r0.x, r0.y, r0.z, r0.w, r1.x, r1.y, r1.z, r1.w, r2.x, r2.y, r2.z, r2.w, r3.x, r3.y, r3.z, r3.w};
    const f32x4v b0 = *(const LAS f32x4v*)(WL + 1024 + k8), b1 = *(const LAS f32x4v*)(WL + 1024 + k8 + 4);
    float acc[8] = {b0.x, b0.y, b0.z, b0.w, b1.x, b1.y, b1.z, b1.w};
#pragma unroll
    for (int j = 0; j < 16; ++j) { const f32x4v w0 = *(const LAS f32x4v*)(WL + j * 64 + k8), w1 = *(const LAS f32x4v*)(WL + j * 64 + k8 + 4);
        acc[0] += rj[j] * w0.x; acc[1] += rj[j] * w0.y; acc[2] += rj[j] * w0.z; acc[3] += rj[j] * w0.w; acc[4] += rj[j] * w1.x; acc[5] += rj[j] * w1.y; acc[6] += rj[j] * w1.z; acc[7] += rj[j] * w1.w; }
#pragma unroll
    for (int q = 0; q < 8; ++q) la[q] = logsigmoid_f(acc[q]) * (1.f / 16.f);
}
__device__ __forceinline__ void gla_loga8r(const LAS float* WL, const f32x4v r0, const f32x4v r1, const f32x4v r2, const f32x4v r3, int k8, float (&la)[8]) {
    const float rj[16] = {r0.x, r0.y, r0.z, r0.w, r1.x, r1.y, r1.z, r1.w, r2.x, r2.y, r2.z, r2.w, r3.x, r3.y, r3.z, r3.w};
    const f32x4v b0 = *(const LAS f32x4v*)(WL + 1024 + k8), b1 = *(const LAS f32x4v*)(WL + 1024 + k8 + 4);
    float acc[8] = {b0.x, b0.y, b0.z, b0.w, b1.x, b1.y, b1.z, b1.w};
#pragma unroll
    for (int j = 0; j < 16; ++j) { const f32x4v w0 = *(const LAS f32x4v*)(WL + j * 64 + k8), w1 = *(const LAS f32x4v*)(WL + j * 64 + k8 + 4);
        acc[0] += rj[j] * w0.x; acc[1] += rj[j] * w0.y; acc[2] += rj[j] * w0.z; acc[3] += rj[j] * w0.w; acc[4] += rj[j] * w1.x; acc[5] += rj[j] * w1.y; acc[6] += rj[j] * w1.z; acc[7] += rj[j] * w1.w; }
#pragma unroll
    for (int q = 0; q < 8; ++q) la[q] = logsigmoid_f(acc[q]) * (1.f / 16.f);
}
__device__ __forceinline__ void col_cumsum64(LAS float* M, int tid, int rev) {
    const int k = tid >> 3, seg = tid & 7; float v[8]; float tot = 0.f;
#pragma unroll
    for (int q = 0; q < 8; ++q) { const int i = rev ? 63 - (seg * 8 + q) : seg * 8 + q; tot += M[i * 65 + k]; v[q] = tot; }
    float run = tot;
#pragma unroll
    for (int o = 1; o < 8; o <<= 1) { const float t = __shfl_up(run, o, 8); if (seg >= o) run += t; }
    const float off = run - tot;
#pragma unroll
    for (int q = 0; q < 8; ++q) { const int i = rev ? 63 - (seg * 8 + q) : seg * 8 + q; M[i * 65 + k] = v[q] + off; }
}

__device__ __forceinline__ void gla_kv_unit(KA a, int l, int uid, LAS unsigned char* lds, int tid) {
    const int s = uid / NCH, n = uid % NCH, dir = s & 1, h = (s >> 1) & 3, b = s >> 3;
    LAS float* CUM = (LAS float*)lds;
    LAS unsigned char* KDT = lds + 16640;
    LAS unsigned char* VT = lds + 16640 + 64 * P144;
    LAS float* WL = (LAS float*)(lds + 16640 + 64 * P144 + 128 * P144);
    gla_stage_w(a, l, dir, h, WL, tid); LDS_BAR();
    const int i = tid >> 3, sub = tid & 7, row = chunk_row(b, dir, n, i);
    { float la[8]; gla_loga8(a, WL, dir, row, sub * 8, la);
#pragma unroll
      for (int q = 0; q < 8; ++q) CUM[i * 65 + sub * 8 + q] = la[q]; }
    LDS_BAR();
    col_cumsum64(CUM, tid, 0);
    LDS_BAR();
    { const v4u kw = *(const v4u*)(a->P + (size_t)row * PW + PC_GLA_K + h * 64 + sub * 8); const unsigned kk[4] = {kw.x, kw.y, kw.z, kw.w};
#pragma unroll
      for (int q = 0; q < 8; ++q) { const int k = sub * 8 + q; const float kv = (q & 1) ? bfhi(kk[q >> 1]) : bflo(kk[q >> 1]);
          *(LAS bf16_t*)(KDT + k * P144 + i * 2) = (bf16_t)f2bf(kv * __expf(CUM[63 * 65 + k] - CUM[i * 65 + k])); }
      const v4u v0 = *(const v4u*)(a->P + (size_t)row * PW + PC_GLA_V + h * 128 + sub * 16), v1 = *(const v4u*)(a->P + (size_t)row * PW + PC_GLA_V + h * 128 + sub * 16 + 8);
      const unsigned vv[8] = {v0.x, v0.y, v0.z, v0.w, v1.x, v1.y, v1.z, v1.w};
#pragma unroll
      for (int q = 0; q < 16; ++q) *(LAS bf16_t*)(VT + (sub * 16 + q) * P144 + i * 2) = (bf16_t)((q & 1) ? (vv[q >> 1] >> 16) : (vv[q >> 1] & 0xffffu)); }
    if (tid < 64) a->GDL[(size_t)uid * 64 + tid] = __expf(CUM[63 * 65 + tid]);
    LDS_BAR();
    { const int wave = tid >> 6, lane = tid & 63, r32 = lane & 31, hi = lane >> 5, mt = wave & 1, nt = wave >> 1;
      f32x16v acc = {};
#pragma unroll
      for (int ks = 0; ks < 4; ++ks) acc = MFMA32(fragL(KDT, P144, 32 * mt + r32, 16 * ks + 8 * hi), fragL(VT, P144, 32 * nt + r32, 16 * ks + 8 * hi), acc);
      float* out = a->GKV + (size_t)uid * 8192 + (size_t)(32 * nt + r32) * 64 + 32 * mt + 4 * hi;
#pragma unroll
      for (int g = 0; g < 4; ++g) *(f32x4v*)(out + 8 * g) = (f32x4v){acc[4 * g], acc[4 * g + 1], acc[4 * g + 2], acc[4 * g + 3]}; }
    LDS_BAR();
}
__device__ __forceinline__ void gla_state_scan(KA a, int tid, int wg, int nwg) {
    for (int e = wg * (NWAVES * 64) + tid; e < 16 * 8192; e += nwg * NWAVES * 64) {
        const int s = e >> 13, vk = e & 8191, k = vk & 63; float S = 0.f;
        const float* kv = a->GKV + (size_t)s * NCH * 8192 + vk; const float* dl = a->GDL + (size_t)s * NCH * 64 + k; bf16_t* st = a->GST + (size_t)s * NCH * 8192 + vk;
#pragma unroll 17
        for (int n = 0; n < NCH; ++n) { st[(size_t)n * 8192] = (bf16_t)f2bf(S); S = dl[n * 64] * S + kv[(size_t)n * 8192]; }
    }
}
struct FinPre { unsigned gw[8]; float g0, g1; };
__device__ __forceinline__ void finish_rows_ld(KA a, int row0, const float* gain, int gatecol, int tid, FinPre& f) {
    const int wave = tid >> 6, lane = tid & 63;
    f.g0 = gain[2 * lane]; f.g1 = gain[2 * lane + 1];
#pragma unroll
    for (int rr = 0; rr < 8; ++rr) f.gw[rr] = *(const unsigned*)(a->P + (size_t)(row0 + wave * 8 + rr) * PW + gatecol + 2 * lane);
}
__device__ __forceinline__ void finish_rows_go(KA a, LAS float* OS, int row0, int mixcol, int tid, const FinPre& f) {
    const int wave = tid >> 6, lane = tid & 63;
    float x0[8], x1[8];
#pragma unroll
    for (int rr = 0; rr < 8; ++rr) { const int t = wave * 8 + rr; x0[rr] = OS[t * 130 + 2 * lane]; x1[rr] = OS[t * 130 + 2 * lane + 1]; }
#pragma unroll
    for (int rr = 0; rr < 8; ++rr) { const int t = wave * 8 + rr;
        const float sc = rsqrtf(wave_sum(x0[rr] * x0[rr] + x1[rr] * x1[rr]) * (1.f / 128.f) + 1e-6f);
        *(unsigned*)(a->MIXB + (size_t)(row0 + t) * DM + mixcol + 2 * lane) = pk2(x0[rr] * sc * f.g0 * silu_f(bflo(f.gw[rr])), x1[rr] * sc * f.g1 * silu_f(bfhi(f.gw[rr]))); }
}
__device__ __forceinline__ void gla_out_unit(KA a, int l, int b, int h, int c, int isctx, LAS unsigned char* lds, int tid) {
    const int row0 = isctx ? NLAT + b * CTX + 64 * c : b * SEQ + 64 * c;
    const int nf = isctx ? c : 4 + c, nb = isctx ? 3 - c : 4 + (63 - c);
    const int uf = ((b * 4 + h) * 2 + 0) * NCH + nf, ub = ((b * 4 + h) * 2 + 1) * NCH + nb;
    LAS float* CF = (LAS float*)lds; LAS float* CB = CF + 64 * 65;
    LAS unsigned char* QF = lds + 33280; LAS unsigned char* KF = QF + 64 * P144; LAS unsigned char* QBk = KF + 64 * P144; LAS unsigned char* KBk = QBk + 64 * P144;
    LAS unsigned char* AM = KBk + 64 * P144;
    LAS unsigned char* VT = AM + 64 * P144;
    LAS float* OS = (LAS float*)lds;
    bf16x8v sfb[8];
    { const int wave_ = tid >> 6, lane_ = tid & 63, r32_ = lane_ & 31, hi_ = lane_ >> 5, nt_ = wave_ & 3;
      const bf16_t* Sf_ = a->GST + (size_t)uf * 8192; const bf16_t* Sb_ = a->GST + (size_t)ub * 8192;
#pragma unroll
      for (int ks = 0; ks < 4; ++ks) { sfb[ks] = fragG(Sf_, 64, 32 * nt_ + r32_, 16 * ks + 8 * hi_); sfb[4 + ks] = fragG(Sb_, 64, 32 * nt_ + r32_, 16 * ks + 8 * hi_); } }
    const int t = tid >> 3, sub = tid & 7, row = row0 + t;
    const f32x4v* rp_ = (const f32x4v*)(a->PG + (size_t)row * 64);
    const f32x4v rf0 = rp_[0], rf1 = rp_[1], rf2 = rp_[2], rf3 = rp_[3], rb0 = rp_[4], rb1 = rp_[5], rb2 = rp_[6], rb3 = rp_[7];
    const v4u qw = *(const v4u*)(a->P + (size_t)row * PW + PC_GLA_Q + h * 64 + sub * 8), kw = *(const v4u*)(a->P + (size_t)row * PW + PC_GLA_K + h * 64 + sub * 8);
    const v4u v0 = *(const v4u*)(a->P + (size_t)row * PW + PC_GLA_V + h * 128 + sub * 16), v1 = *(const v4u*)(a->P + (size_t)row * PW + PC_GLA_V + h * 128 + sub * 16 + 8);
    FinPre fp; finish_rows_ld(a, row0, a->gla_norm + l * 128, PC_GLA_G + h * 128, tid, fp);
    LAS float* WL0 = (LAS float*)(lds + 98304); LAS float* WL1 = WL0 + 1088;
    gla_stage_w(a, l, 0, h, WL0, tid); gla_stage_w(a, l, 1, h, WL1, tid); LDS_BAR();
    { float la[8]; gla_loga8r(WL0, rf0, rf1, rf2, rf3, sub * 8, la);
#pragma unroll
      for (int q = 0; q < 8; ++q) CF[t * 65 + sub * 8 + q] = la[q];
      gla_loga8r(WL1, rb0, rb1, rb2, rb3, sub * 8, la);
#pragma unroll
      for (int q = 0; q < 8; ++q) CB[t * 65 + sub * 8 + q] = la[q]; }
    LDS_BAR();
    col_cumsum64(CF, tid, 0); col_cumsum64(CB, tid, 1);
    LDS_BAR();
    { const unsigned qq[4] = {qw.x, qw.y, qw.z, qw.w}, kk[4] = {kw.x, kw.y, kw.z, kw.w};
      unsigned oqf[4], okf[4], oqb[4], okb[4];
#pragma unroll
      for (int p = 0; p < 4; ++p) { const int k0 = sub * 8 + 2 * p; const float q0 = bflo(qq[p]), q1 = bfhi(qq[p]), k0v = bflo(kk[p]), k1v = bfhi(kk[p]);
          const float cf0 = CF[t * 65 + k0], cf1 = CF[t * 65 + k0 + 1], cb0 = CB[t * 65 + k0], cb1 = CB[t * 65 + k0 + 1];
          oqf[p] = pk2(q0 * __expf(cf0), q1 * __expf(cf1)); okf[p] = pk2(k0v * __expf(-cf0), k1v * __expf(-cf1));
          oqb[p] = pk2(q0 * __expf(cb0), q1 * __expf(cb1)); okb[p] = pk2(k0v * __expf(-cb0), k1v * __expf(-cb1)); }
      *(LAS v4u*)(QF + t * P144 + sub * 16) = (v4u){oqf[0], oqf[1], oqf[2], oqf[3]}; *(LAS v4u*)(KF + t * P144 + sub * 16) = (v4u){okf[0], okf[1], okf[2], okf[3]};
      *(LAS v4u*)(QBk + t * P144 + sub * 16) = (v4u){oqb[0], oqb[1], oqb[2], oqb[3]}; *(LAS v4u*)(KBk + t * P144 + sub * 16) = (v4u){okb[0], okb[1], okb[2], okb[3]};
      const unsigned vv[8] = {v0.x, v0.y, v0.z, v0.w, v1.x, v1.y, v1.z, v1.w};
#pragma unroll
      for (int q = 0; q < 16; ++q) *(LAS bf16_t*)(VT + (sub * 16 + q) * P144 + t * 2) = (bf16_t)((q & 1) ? (vv[q >> 1] >> 16) : (vv[q >> 1] & 0xffffu)); }
    LDS_BAR();
    const int wave = tid >> 6, lane = tid & 63, r32 = lane & 31, hi = lane >> 5;
    if (wave < 4) {
        const int mt = wave >> 1, nt = wave & 1; f32x16v af = {}, ab = {};
#pragma unroll
        for (int ks = 0; ks < 4; ++ks) { af = MFMA32(fragL(QF, P144, 32 * mt + r32, 16 * ks + 8 * hi), fragL(KF, P144, 32 * nt + r32, 16 * ks + 8 * hi), af);
                                         ab = MFMA32(fragL(QBk, P144, 32 * mt + r32, 16 * ks + 8 * hi), fragL(KBk, P144, 32 * nt + r32, 16 * ks + 8 * hi), ab); }
        const int sc = 32 * nt + r32;
#pragma unroll
        for (int r = 0; r < 16; ++r) { const int tt = 32 * mt + crow_(r, hi); const float v = (sc <= tt ? af[r] : 0.f) + (sc >= tt ? ab[r] : 0.f);
            *(LAS bf16_t*)(AM + tt * P144 + sc * 2) = (bf16_t)f2bf(v); }
    }
    LDS_BAR();
    { const int mt = wave >> 2, nt = wave & 3; f32x16v o = {};
#pragma unroll
      for (int ks = 0; ks < 4; ++ks) { const int k0 = 16 * ks + 8 * hi;
          o = MFMA32(fragL(AM, P144, 32 * mt + r32, k0), fragL(VT, P144, 32 * nt + r32, k0), o);
          o = MFMA32(fragL(QF, P144, 32 * mt + r32, k0), sfb[ks], o);
          o = MFMA32(fragL(QBk, P144, 32 * mt + r32, k0), sfb[4 + ks], o); }
#pragma unroll
      for (int r = 0; r < 16; ++r) OS[(32 * mt + crow_(r, hi)) * 130 + 32 * nt + r32] = o[r] * 0.125f; }
    LDS_BAR();
    finish_rows_go(a, OS, row0, h * 128, tid, fp);
    LDS_BAR();
}
__device__ __forceinline__ void gdn_chunk_unit(KA a, int uid, LAS unsigned char* lds, int tid) {
    const int s = uid / NCH, n = uid % NCH, dir = s & 1, h = (s >> 1) & 3, b = s >> 3;
    LAS unsigned char* KS = lds; LAS unsigned char* QS = lds + 17408;
    LAS unsigned char* VT = lds + 34816; LAS unsigned char* KBT = lds + 53248; LAS unsigned char* KDT = lds + 71680;
    LAS float* LF = (LAS float*)(lds + 90112); LAS float* TA = (LAS float*)(lds + 106752);
    LAS float* GC = (LAS float*)(lds + 123392); LAS float* BT = GC + 64;
    LAS unsigned char* TS = QS;
    const int wave = tid >> 6, lane = tid & 63, r32 = lane & 31, hi = lane >> 5;
    if (wave == 0) { const int row = chunk_row(b, dir, n, lane);
        float c = a->GG[((size_t)dir * NROW + row) * 4 + h];
#pragma unroll
        for (int o = 1; o < 64; o <<= 1) { const float t = __shfl_up(c, o); if (lane >= o) c += t; }
        GC[lane] = c; BT[lane] = a->BETA[((size_t)dir * NROW + row) * 4 + h]; }
    LDS_BAR();
    const int i = tid >> 3, sub = tid & 7;
    { const int row = chunk_row(b, dir, n, i); const bf16_t* gp = a->GQKV + (size_t)row * 1536 + h * 128 + sub * 16;
      const v4u q0 = *(const v4u*)gp, q1 = *(const v4u*)(gp + 8), k0 = *(const v4u*)(gp + 512), k1 = *(const v4u*)(gp + 520), v0 = *(const v4u*)(gp + 1024), v1 = *(const v4u*)(gp + 1032);
      *(LAS v4u*)(KS + i * P272 + sub * 32) = k0; *(LAS v4u*)(KS + i * P272 + sub * 32 + 16) = k1;
      *(LAS v4u*)(QS + i * P272 + sub * 32) = q0; *(LAS v4u*)(QS + i * P272 + sub * 32 + 16) = q1;
      const float gci = GC[i], bi = BT[i], eg = __expf(gci), ed = __expf(GC[63] - gci);
      const unsigned qq[8] = {q0.x, q0.y, q0.z, q0.w, q1.x, q1.y, q1.z, q1.w}, kk[8] = {k0.x, k0.y, k0.z, k0.w, k1.x, k1.y, k1.z, k1.w}, vv[8] = {v0.x, v0.y, v0.z, v0.w, v1.x, v1.y, v1.z, v1.w};
      unsigned qd[8];
#pragma unroll
      for (int p = 0; p < 8; ++p) { const int d = sub * 16 + 2 * p; const float ka = bflo(kk[p]), kb = bfhi(kk[p]);
          *(LAS bf16_t*)(VT + d * P144 + i * 2) = (bf16_t)f2bf(bi * bflo(vv[p])); *(LAS bf16_t*)(VT + (d + 1) * P144 + i * 2) = (bf16_t)f2bf(bi * bfhi(vv[p]));
          *(LAS bf16_t*)(KBT + d * P144 + i * 2) = (bf16_t)f2bf(bi * eg * ka); *(LAS bf16_t*)(KBT + (d + 1) * P144 + i * 2) = (bf16_t)f2bf(bi * eg * kb);
          *(LAS bf16_t*)(KDT + d * P144 + i * 2) = (bf16_t)f2bf(ed * ka); *(LAS bf16_t*)(KDT + (d + 1) * P144 + i * 2) = (bf16_t)f2bf(ed * kb);
          qd[p] = pk2(eg * bflo(qq[p]), eg * bfhi(qq[p])); }
      const int ir = dir ? 63 - i : i;
      bf16_t* qo = a->QDG + (size_t)uid * 8192 + (size_t)((((ir >> 5) * 8 + sub) * 64 + (ir & 31)) * 8);
      *(v4u*)qo = (v4u){qd[0], qd[1], qd[2], qd[3]}; *(v4u*)(qo + 32 * 8) = (v4u){qd[4], qd[5], qd[6], qd[7]}; }
    LDS_BAR();
    { const int which = wave >> 2, mt = (wave >> 1) & 1, nt = wave & 1; const LAS unsigned char* Am = which ? QS : KS; f32x16v acc = {};
#pragma unroll
      for (int ks = 0; ks < 8; ++ks) acc = MFMA32(fragL(Am, P272, 32 * mt + r32, 16 * ks + 8 * hi), fragL(KS, P272, 32 * nt + r32, 16 * ks + 8 * hi), acc);
      const int j = 32 * nt + r32; const float gcj = GC[j];
#pragma unroll
      for (int r = 0; r < 16; ++r) { const int ii = 32 * mt + crow_(r, hi); const float gam = (ii >= j) ? __expf(GC[ii] - gcj) : 0.f;
          if (which == 0) LF[ii * 65 + j] = (ii > j) ? BT[ii] * acc[r] * gam : 0.f;
          else { const int ir = dir ? 63 - ii : ii; a->AIG[(size_t)uid * 4096 + (size_t)((((ir >> 5) * 4 + (j >> 4)) * 64 + ((j >> 3) & 1) * 32 + (ir & 31)) * 8 + (j & 7))] = (bf16_t)f2bf((ii >= j) ? acc[r] * gam : 0.f); } } }
    LDS_BAR();
    if (wave < 4) { const int I = wave, c = lane & 15; float col[16], lrow[16];
#pragma unroll
        for (int ii = 0; ii < 16; ++ii) lrow[ii] = LF[(16 * I + ii) * 65 + 16 * I + c];
#pragma unroll
        for (int ii = 0; ii < 16; ++ii) { float acc = -lrow[ii];
#pragma unroll
            for (int j = 1; j < ii; ++j) { const float lij = __builtin_bit_cast(float, __builtin_amdgcn_readlane(__builtin_bit_cast(int, lrow[ii]), j)); acc -= (j > c) ? lij * col[j] : 0.f; }
            col[ii] = acc; }
        if (lane < 16) {
#pragma unroll
            for (int ii = 0; ii < 16; ++ii) TA[(16 * I + ii) * 65 + 16 * I + c] = (ii == c) ? 1.f : col[ii]; } }
    { LAS float* XW = (LAS float*)(lds + 123904) + wave * 272; const int r = lane >> 2, c4 = (lane & 3) * 4;
      for (int d = 1; d < 4; ++d) {
        LDS_BAR();
        if (wave < 4 - d) { const int J = wave, I = wave + d; float x[4] = {0.f, 0.f, 0.f, 0.f};
            for (int K = J; K < I; ++K) { float av[16], tv[64];
#pragma unroll
                for (int k = 0; k < 16; ++k) av[k] = LF[(16 * I + r) * 65 + 16 * K + k];
#pragma unroll
                for (int k = 0; k < 16; ++k) {
#pragma unroll
                    for (int q = 0; q < 4; ++q) tv[4 * k + q] = TA[(16 * K + k) * 65 + 16 * J + c4 + q]; }
#pragma unroll
                for (int k = 0; k < 16; ++k) {
#pragma unroll
                    for (int q = 0; q < 4; ++q) x[q] += av[k] * tv[4 * k + q]; } }
#pragma unroll
            for (int q = 0; q < 4; ++q) XW[r * 17 + c4 + q] = x[q];
            float y[4] = {0.f, 0.f, 0.f, 0.f}; float av[16], tv[64];
#pragma unroll
            for (int k = 0; k < 16; ++k) av[k] = TA[(16 * I + r) * 65 + 16 * I + k];
#pragma unroll
            for (int k = 0; k < 16; ++k) {
#pragma unroll
                for (int q = 0; q < 4; ++q) tv[4 * k + q] = XW[k * 17 + c4 + q]; }
#pragma unroll
            for (int k = 0; k < 16; ++k) {
#pragma unroll
                for (int q = 0; q < 4; ++q) y[q] -= av[k] * tv[4 * k + q]; }
#pragma unroll
            for (int q = 0; q < 4; ++q) TA[(16 * I + r) * 65 + 16 * J + c4 + q] = y[q]; }
      } }
    LDS_BAR();
    { float tv[8];
#pragma unroll
      for (int q = 0; q < 8; ++q) { const int j = sub * 8 + q; tv[q] = (j <= i) ? TA[i * 65 + j] : 0.f; }
      *(LAS v4u*)(TS + i * P144 + sub * 16) = (v4u){pk2(tv[0], tv[1]), pk2(tv[2], tv[3]), pk2(tv[4], tv[5]), pk2(tv[6], tv[7])}; }
    LDS_BAR();
    { const int mt = wave >> 2, nt = wave & 3; f32x16v u = {}, w = {};
#pragma unroll
      for (int ks = 0; ks < 4; ++ks) { const bf16x8v tf = fragL(TS, P144, 32 * mt + r32, 16 * ks + 8 * hi);
          u = MFMA32(tf, fragL(VT, P144, 32 * nt + r32, 16 * ks + 8 * hi), u); w = MFMA32(tf, fragL(KBT, P144, 32 * nt + r32, 16 * ks + 8 * hi), w); }
      float* uo = a->UG + (size_t)uid * 8192; bf16_t* wo = a->WG + (size_t)uid * 8192;
#pragma unroll
      for (int r = 0; r < 16; ++r) { const int o = (32 * mt + crow_(r, hi)) * 128 + 32 * nt + r32; uo[o] = u[r]; wo[o] = (bf16_t)f2bf(w[r]); } }
    { const int d = tid >> 2, part = tid & 3; bf16_t* ko = a->KDTG + (size_t)uid * 8192 + d * 64 + part * 16;
      *(v4u*)ko = *(const LAS v4u*)(KDT + d * P144 + part * 32); *(v4u*)(ko + 8) = *(const LAS v4u*)(KDT + d * P144 + part * 32 + 16); }
    if (tid == 0) a->DLASTG[uid] = __expf(GC[63]);
    LDS_BAR();
}
#define ALD16(dst, ptr) asm volatile("global_load_dwordx4 %0, %1, off" : "=v"(dst) : "v"(ptr) : "memory")
#define ALD4(dst, ptr) asm volatile("global_load_dword %0, %1, off" : "=v"(dst) : "v"(ptr) : "memory")
#define ALD16O(dst, ptr, OFF) asm volatile("global_load_dwordx4 %0, %1, off offset:" #OFF : "=v"(dst) : "v"(ptr) : "memory")
#define ALD4O(dst, ptr, OFF) asm volatile("global_load_dword %0, %1, off offset:" #OFF : "=v"(dst) : "v"(ptr) : "memory")
__device__ __forceinline__ void gdn_scan_unit(KA a, int s, int sl, LAS unsigned char* lds, int tid) {
    LAS unsigned char* SB = lds; LAS unsigned char* VN = lds + 32 * P272;
    const int wave = __builtin_amdgcn_readfirstlane(tid >> 6);
    const size_t u0 = (size_t)s * NCH;
#define ROLE_LANE() int lane = tid & 63; asm volatile("" : "+v"(lane)); const int r32 = lane & 31, hi = lane >> 5; (void)r32; (void)hi
    if (wave < 4) {
        ROLE_LANE();
        f32x16v S = {}; bf16x8v kdA[4], kdB[4], kdC[4]; float dlA, dlB, dlC;
#define LD_S(kd, dl, n_) do { const size_t uid_ = u0 + ((n_) < NCH ? (n_) : NCH - 1); const bf16_t* p_ = a->KDTG + uid_ * 8192 + (size_t)(32 * wave + r32) * 64 + 8 * hi; \
            ALD16O(kd[0], p_, 0); ALD16O(kd[1], p_, 32); ALD16O(kd[2], p_, 64); ALD16O(kd[3], p_, 96); const float* q_ = a->DLASTG + uid_; ALD4(dl, q_); } while (0)
#define WAIT_S(kd, dl, N) asm volatile("s_waitcnt vmcnt(" #N ")" : "+v"(kd[0]), "+v"(kd[1]), "+v"(kd[2]), "+v"(kd[3]), "+v"(dl) :: "memory")
#define ST_S() do { _Pragma("unroll") for (int g = 0; g < 4; ++g) { \
            const unsigned long long pk = (unsigned long long)pg8::cvt_pk_bf16(S[4 * g], S[4 * g + 1]) | ((unsigned long long)pg8::cvt_pk_bf16(S[4 * g + 2], S[4 * g + 3]) << 32); const int d0 = 32 * wave + 8 * g + 4 * hi; \
            *(LAS unsigned long long*)(SB + r32 * P272 + d0 * 2) = pk; } } while (0)
#define UP_S(kd, dl) do { bf16x8v bf_[4]; _Pragma("unroll") for (int ks = 0; ks < 4; ++ks) bf_[ks] = fragL(VN, P144, r32, 16 * ks + 8 * hi); S = S * dl; \
            _Pragma("unroll") for (int ks = 0; ks < 4; ++ks) S = MFMA32(kd[ks], bf_[ks], S); } while (0)
        LD_S(kdA, dlA, 0); LD_S(kdB, dlB, 1);
        for (int n = 0; n < NCH - 2; n += 3) {
            LD_S(kdC, dlC, n + 2); ST_S(); LDS_BAR(); LDS_BAR(); WAIT_S(kdA, dlA, 10); UP_S(kdA, dlA);
            LD_S(kdA, dlA, n + 3); ST_S(); LDS_BAR(); LDS_BAR(); WAIT_S(kdB, dlB, 10); UP_S(kdB, dlB);
            LD_S(kdB, dlB, n + 4); ST_S(); LDS_BAR(); LDS_BAR(); WAIT_S(kdC, dlC, 10); UP_S(kdC, dlC);
        }
        ST_S(); LDS_BAR(); LDS_BAR(); WAIT_S(kdA, dlA, 5); UP_S(kdA, dlA);
        ST_S(); LDS_BAR(); LDS_BAR(); WAIT_S(kdB, dlB, 0); UP_S(kdB, dlB);
#undef LD_S
#undef WAIT_S
#undef ST_S
#undef UP_S
    } else if (wave < 6) {
        ROLE_LANE();
        const int mt = wave - 4; bf16x8v wfA[8], wfB[8], wfC[8]; float uuA[16], uuB[16], uuC[16];
#define LD_V(wf, uu, n_) do { const size_t uid_ = u0 + ((n_) < NCH ? (n_) : NCH - 1); const bf16_t* p_ = a->WG + uid_ * 8192 + (size_t)(32 * mt + r32) * 128 + 8 * hi; \
            ALD16O(wf[0], p_, 0); ALD16O(wf[1], p_, 32); ALD16O(wf[2], p_, 64); ALD16O(wf[3], p_, 96); ALD16O(wf[4], p_, 128); ALD16O(wf[5], p_, 160); ALD16O(wf[6], p_, 192); ALD16O(wf[7], p_, 224); \
            const float* q_ = a->UG + uid_ * 8192 + (size_t)(32 * mt + 4 * hi) * 128 + 32 * sl + r32;     \
            ALD4O(uu[0], q_, 0); ALD4O(uu[1], q_, 512); ALD4O(uu[2], q_, 1024); ALD4O(uu[3], q_, 1536); const float* q1_ = q_ + 1024; \
            ALD4O(uu[4], q1_, 0); ALD4O(uu[5], q1_, 512); ALD4O(uu[6], q1_, 1024); ALD4O(uu[7], q1_, 1536); const float* q2_ = q_ + 2048; \
            ALD4O(uu[8], q2_, 0); ALD4O(uu[9], q2_, 512); ALD4O(uu[10], q2_, 1024); ALD4O(uu[11], q2_, 1536); const float* q3_ = q_ + 3072; \
            ALD4O(uu[12], q3_, 0); ALD4O(uu[13], q3_, 512); ALD4O(uu[14], q3_, 1024); ALD4O(uu[15], q3_, 1536); } while (0)
#define WAIT_V(wf, uu, N) asm volatile("s_waitcnt vmcnt(" #N ")" : "+v"(wf[0]), "+v"(wf[1]), "+v"(wf[2]), "+v"(wf[3]), "+v"(wf[4]), "+v"(wf[5]), "+v"(wf[6]), "+v"(wf[7]), \
            "+v"(uu[0]), "+v"(uu[1]), "+v"(uu[2]), "+v"(uu[3]), "+v"(uu[4]), "+v"(uu[5]), "+v"(uu[6]), "+v"(uu[7]), "+v"(uu[8]), "+v"(uu[9]), "+v"(uu[10]), "+v"(uu[11]), "+v"(uu[12]), "+v"(uu[13]), "+v"(uu[14]), "+v"(uu[15]) :: "memory")
#define VN_STEP(wf, uu) do { f32x16v t = {}; bf16x8v bf_[4]; _Pragma("unroll") for (int ks = 0; ks < 4; ++ks) bf_[ks] = fragL(SB, P272, r32, 16 * ks + 8 * hi); \
            _Pragma("unroll") for (int ks = 0; ks < 4; ++ks) t = MFMA32(wf[ks], bf_[ks], t); \
            _Pragma("unroll") for (int ks = 0; ks < 4; ++ks) bf_[ks] = fragL(SB, P272, r32, 16 * (ks + 4) + 8 * hi); \
            _Pragma("unroll") for (int ks = 0; ks < 4; ++ks) t = MFMA32(wf[ks + 4], bf_[ks], t); \
            _Pragma("unroll") for (int g = 0; g < 4; ++g) { \
                const unsigned long long pk = (unsigned long long)pg8::cvt_pk_bf16(uu[4 * g] - t[4 * g], uu[4 * g + 1] - t[4 * g + 1]) | ((unsigned long long)pg8::cvt_pk_bf16(uu[4 * g + 2] - t[4 * g + 2], uu[4 * g + 3] - t[4 * g + 3]) << 32); \
                const int i0 = 32 * mt + 8 * g + 4 * hi; \
                *(LAS unsigned long long*)(VN + r32 * P144 + i0 * 2) = pk; } } while (0)
        LD_V(wfA, uuA, 0); LD_V(wfB, uuB, 1);
        for (int n = 0; n < NCH - 2; n += 3) {
            LD_V(wfC, uuC, n + 2); LDS_BAR(); WAIT_V(wfA, uuA, 48); VN_STEP(wfA, uuA); LDS_BAR();
            LD_V(wfA, uuA, n + 3); LDS_BAR(); WAIT_V(wfB, uuB, 48); VN_STEP(wfB, uuB); LDS_BAR();
            LD_V(wfB, uuB, n + 4); LDS_BAR(); WAIT_V(wfC, uuC, 48); VN_STEP(wfC, uuC); LDS_BAR();
        }
        LDS_BAR(); WAIT_V(wfA, uuA, 24); VN_STEP(wfA, uuA); LDS_BAR();
        LDS_BAR(); WAIT_V(wfB, uuB, 0); VN_STEP(wfB, uuB); LDS_BAR();
#undef LD_V
#undef WAIT_V
#undef VN_STEP
    } else if (wave == 6) {
        ROLE_LANE();
        v4u tA[8], tB[8], tC[8], tD[8];
#define PUB_S(t, n_) do { LDS_BAR(); \
            _Pragma("unroll") for (int it = 0; it < 8; ++it) t[it] = *(const LAS v4u*)(SB + r32 * P272 + (2 * it + hi) * 16); \
            LDS_BAR(); bf16_t* dst = a->SPREV + (u0 + (n_)) * 16384 + (size_t)(sl * 8 * 64 + r32 + 32 * hi) * 8; \
            _Pragma("unroll") for (int it = 0; it < 8; ++it) *(v4u*)(dst + it * 512) = t[it]; } while (0)
        for (int n = 0; n < NCH; n += 4) { PUB_S(tA, n); PUB_S(tB, n + 1); PUB_S(tC, n + 2); PUB_S(tD, n + 3); }
#undef PUB_S
    } else {
        ROLE_LANE(); v4u tA[4], tB[4], tC[4], tD[4];
#define PUB_V(t, n_) do { LDS_BAR(); LDS_BAR(); \
            _Pragma("unroll") for (int it = 0; it < 4; ++it) t[it] = *(const LAS v4u*)(VN + r32 * P144 + (2 * it + hi) * 16); \
            bf16_t* dst = a->VNEW + (u0 + (n_)) * 8192 + (size_t)(sl * 4 * 64 + r32 + 32 * hi) * 8; \
            _Pragma("unroll") for (int it = 0; it < 4; ++it) *(v4u*)(dst + it * 512) = t[it]; } while (0)
        for (int n = 0; n < NCH; n += 4) { PUB_V(tA, n); PUB_V(tB, n + 1); PUB_V(tC, n + 2); PUB_V(tD, n + 3); }
#undef PUB_V
    }
#undef ROLE_LANE
    __syncthreads();
}
__device__ __forceinline__ void gdn_out_unit(KA a, int l, int b, int h, int c, int isctx, LAS unsigned char* lds, int tid) {
    const int row0 = isctx ? NLAT + b * CTX + 64 * c : b * SEQ + 64 * c;
    const int nf = isctx ? c : 4 + c, nb = isctx ? 3 - c : 4 + (63 - c);
    LAS float* OS = (LAS float*)lds;
    const int wave = tid >> 6, lane = tid & 63, r32 = lane & 31, hi = lane >> 5, mt = wave >> 2, nt = wave & 3;
    f32x16v o = {};
    bf16x8v fa[24], fb[24]; FinPre fp;
#pragma unroll
    for (int dsel = 0; dsel < 2; ++dsel) { const size_t uid = (size_t)((b * 4 + h) * 2 + dsel) * NCH + (dsel ? nb : nf);
        const bf16_t* QDp = a->QDG + uid * 8192; const bf16_t* AIp = a->AIG + uid * 4096; const bf16_t* SP = a->SPREV + uid * 16384; const bf16_t* VNp = a->VNEW + uid * 8192;
#pragma unroll
        for (int ks = 0; ks < 8; ++ks) { fa[12 * dsel + ks] = *(const bf16x8v*)(QDp + ((mt * 8 + ks) * 64 + lane) * 8); fb[12 * dsel + ks] = *(const bf16x8v*)(SP + ((nt * 8 + ks) * 64 + lane) * 8); }
#pragma unroll
        for (int ks = 0; ks < 4; ++ks) { fa[12 * dsel + 8 + ks] = *(const bf16x8v*)(AIp + ((mt * 4 + ks) * 64 + lane) * 8); fb[12 * dsel + 8 + ks] = *(const bf16x8v*)(VNp + ((nt * 4 + ks) * 64 + lane) * 8); } }
    finish_rows_ld(a, row0, a->gdn_norm + l * 128, PC_GDN_Z + h * 128, tid, fp);
#pragma unroll
    for (int ks = 0; ks < 24; ++ks) o = MFMA32(fa[ks], fb[ks], o);
#pragma unroll
    for (int r = 0; r < 16; ++r) OS[(32 * mt + crow_(r, hi)) * 130 + 32 * nt + r32] = o[r];
    LDS_BAR();
    finish_rows_go(a, OS, row0, 512 + h * 128, tid, fp);
    LDS_BAR();
}
__device__ __forceinline__ void phase_attn(KA a, int layer0, char* ldsg, int first_unit_shift) {
    const int nunits = layer0 ? 272 : 256; bool firstu = true;
    const int G_ = gridDim.x, cshift = (G_ == 256) ? (int)((blockIdx.x + 192u) & 255u) : (int)blockIdx.x;
    for (int uu = cshift; uu < nunits; uu += G_) {
        const int u = uu;
        if (!firstu) __syncthreads();
        firstu = false;
        const bf16_t *Qp, *Kp, *Vp; bf16_t* Op; int seq;
        if (u < 256) { const int b = u >> 7, hq = (u >> 4) & 7, qb = u & 15, kvh = hq >> 2; seq = NKEY;
            Qp = a->QB + (size_t)(b * SEQ + qb * 256) * 1024 + hq * 128; Kp = a->KB + ((size_t)(b * NKEY) * 2 + kvh) * 128; Vp = a->VB + ((size_t)(b * NKEY) * 2 + kvh) * 128;
            Op = a->MIXB + (size_t)(b * SEQ + qb * 256) * DM + 1024 + hq * 128; }
        else { const int u2 = u - 256, b = u2 >> 3, hq = u2 & 7, kvh = hq >> 2; seq = CTX;
            Qp = a->QB + (size_t)(NLAT + b * CTX) * 1024 + hq * 128; Kp = a->KB + ((size_t)(b * NKEY) * 2 + kvh) * 128; Vp = a->VB + ((size_t)(b * NKEY) * 2 + kvh) * 128;
            Op = a->MIXB + (size_t)(NLAT + b * CTX) * DM + 1024 + hq * 128; }
        att::attn_dense_body<att::bf16>(Qp, Kp, Vp, Op, seq, ldsg);
    }
}
__global__ void __launch_bounds__(NWAVES * 64, 2) __attribute__((amdgpu_waves_per_eu(2, 2))) mega(Args karg) {
    extern __shared__ __attribute__((aligned(16))) unsigned char lds_raw[];
    LAS unsigned char* lds = (LAS unsigned char*)lds_raw;
    const int tid = threadIdx.x, lane = tid & 63, wave = __builtin_amdgcn_readfirstlane(tid >> 6);
    for (int u = tid; u < (LDS_BYTES - LDSCTL_OFF) / 4; u += NWAVES * 64) ((LAS unsigned*)(lds + LDSCTL_OFF))[u] = 0u;
    __syncthreads();
    KA a0 = (KA)__builtin_amdgcn_kernarg_segment_ptr();
#define KARGS() KA a = a0; asm volatile("" : "+s"(a))
    const int lo = a0->ph_lo, hi = a0->ph_hi;
    unsigned* const barw = a0->ctl + CW_BAR + a0->li * XCD_BAR_WORDS; XcdBarrier bar; bar.bar = barw; bar.x = 0; bar.st = nullptr;
    if (hi - lo > 1) bar = xcd_barrier_post(barw, (volatile LAS unsigned*)(lds + MISC_OFF + 32));
#define IN(k) (lo <= (k) && (k) < hi)
#define SEAM(k) do { if (IN(k) && IN((k) + 1)) xcd_barrier(bar); } while (0)

    if (IN(PH_CONV)) { KARGS(); int ln = lane; asm volatile("" : "+v"(ln)); phase_convert(a, lds, wave, ln); } SEAM(PH_CONV);
    if (IN(PH_INIT)) { KARGS(); int ln = lane; asm volatile("" : "+v"(ln)); phase_init(a, wave, ln); } SEAM(PH_INIT);
#define OPQ(p) asm volatile("" : "+s"(p))
#pragma unroll 1
    for (int l = 0; l < 2; ++l) {
        const int pb = NPH_PRO + l * NPH_LAYER; const int layer0 = (l == 0);
        if (IN(pb + L_INPROJ)) { KARGS();
            const bf16_t* Ap = a->HB; const bf16_t* Bp = a->WinT + l * WINT_L; bf16_t* O1 = a->P; float* O2 = a->PG; OPQ(Ap); OPQ(Bp); OPQ(O1); OPQ(O2);
            pg8::Gemm g{Ap, Bp, NROW, NINP, DM}; pg8::StaticOrder S; S.init(NROW, NINP, gridDim.x, blockIdx.x);
            pg8::EpiInProj E{O1, O2};
            pg8::gemm_phase<pg8::EpiInProj, pg8::StaticOrder>(lds, g, S, E, nullptr);
        } SEAM(pb + L_INPROJ);
        if (IN(pb + L_PREP)) { KARGS(); int ln = lane; asm volatile("" : "+v"(ln)); phase_prep(a, l, lds, wave, ln); } SEAM(pb + L_PREP);
        if (IN(pb + L_CHUNK)) { KARGS(); int td = tid; asm volatile("" : "+v"(td));
            for (int uid = blockIdx.x; uid < 16 * NCH; uid += gridDim.x) gdn_chunk_unit(a, uid, lds, td);
            if (gridDim.x == 256) {
                const int g0 = blockIdx.x < 64 ? (int)blockIdx.x * 2 : 128 + ((int)blockIdx.x - 64) * 5, gn = blockIdx.x < 64 ? 2 : 5;
                for (int q = 0; q < gn; ++q) gla_kv_unit(a, l, g0 + q, lds, td);
            } else for (int uid = gridDim.x - 1 - blockIdx.x; uid < 16 * NCH; uid += gridDim.x) gla_kv_unit(a, l, uid, lds, td);
        } SEAM(pb + L_CHUNK);
        if (IN(pb + L_SCAN)) { KARGS(); { int td = tid; asm volatile("" : "+v"(td));
                { const bool side = gridDim.x == 256;
                  if (!side || blockIdx.x >= 64) gla_state_scan(a, td, side ? (int)blockIdx.x - 64 : (int)blockIdx.x, side ? 192 : (int)gridDim.x);
                  for (int su = blockIdx.x; su < 64; su += gridDim.x) gdn_scan_unit(a, su >> 2, su & 3, lds, td); }
                }
            phase_attn(a, layer0, (char*)lds_raw, 0);
            if (gridDim.x == 256 && blockIdx.x >= 64) { __syncthreads(); int ln = lane; asm volatile("" : "+v"(ln)); int wv = wave; asm volatile("" : "+s"(wv));
                conv_range(a, lds, wv, ln, layer0 ? CONV_N0 : CONV_NC, layer0 ? CONV_NA : CONV_NALL, blockIdx.x - 64, 192); } } SEAM(pb + L_SCAN);
        if (IN(pb + L_OUT)) { KARGS(); int td = tid; asm volatile("" : "+v"(td));
            const int nu = layer0 ? 544 : 512;
            for (int u = blockIdx.x; u < nu; u += gridDim.x) { if (u < 512) gdn_out_unit(a, l, u >> 8, (u >> 6) & 3, u & 63, 0, lds, td); else gdn_out_unit(a, l, (u - 512) >> 4, ((u - 512) >> 2) & 3, (u - 512) & 3, 1, lds, td); }
            for (int u = gridDim.x - 1 - blockIdx.x; u < nu; u += gridDim.x) { if (u < 512) gla_out_unit(a, l, u >> 8, (u >> 6) & 3, u & 63, 0, lds, td); else gla_out_unit(a, l, (u - 512) >> 4, ((u - 512) >> 2) & 3, (u - 512) & 3, 1, lds, td); }
        } SEAM(pb + L_OUT);
        if (IN(pb + L_OPROJ)) { KARGS();
            const int nrows = layer0 ? NROW : NLAT;
            const bf16_t* Ap = a->MIXB; const bf16_t* Bp = a->WoutT + l * WOUTT_L; float* O1 = a->Y; OPQ(Ap); OPQ(Bp); OPQ(O1);
            pg8::Gemm g{Ap, Bp, nrows, DM, DM}; pg8::StaticOrder S; S.init(nrows, DM, gridDim.x, blockIdx.x);
            pg8::EpiF32 E{O1, DM, nullptr};
            pg8::gemm_phase<pg8::EpiF32, pg8::StaticOrder>(lds, g, S, E, nullptr);
            if (gridDim.x == 256 && layer0 && blockIdx.x >= 16) { int ln = lane; asm volatile("" : "+v"(ln)); int wv = wave; asm volatile("" : "+s"(wv)); conv_range(a, lds, wv, ln, CONV_NA, CONV_NB, blockIdx.x - 16, 240); }
        } SEAM(pb + L_OPROJ);
        if (IN(pb + L_LN1)) { KARGS(); int ln = lane; asm volatile("" : "+v"(ln)); phase_ln1(a, l, layer0 ? NROW : NLAT, lds, wave, ln); } SEAM(pb + L_LN1);
        if (IN(pb + L_TOPK)) { KARGS(); int td = tid; asm volatile("" : "+v"(td)); phase_topk(a, layer0, lds, td); } SEAM(pb + L_TOPK);
        if (IN(pb + L_FFN1)) { KARGS();
            const bf16_t* Ap = a->XS; const bf16_t* Bp = a->W13T + l * W13T_L; bf16_t* O1 = a->HM; OPQ(Ap); OPQ(Bp); OPQ(O1);
            pg8::Gemm g{Ap, Bp, XSROWS, NEXP * 4096, DM}; pg8::OrderFfn1 S{(int)gridDim.x, (int)blockIdx.x, layer0};
            pg8::EpiSwiGLU E{O1};
            pg8::gemm_phase<pg8::EpiSwiGLU, pg8::OrderFfn1>(lds, g, S, E, nullptr);
        } SEAM(pb + L_FFN1);
        if (IN(pb + L_FFN2)) { KARGS();
            const bf16_t* Ap = a->HM; const bf16_t* Bp = a->W2T + l * W2T_L; bf16_t* O1 = a->YE; OPQ(Ap); OPQ(Bp); OPQ(O1);
            pg8::Gemm g{Ap, Bp, XSROWS, NEXP * DM, EFF}; pg8::OrderFfn2 S{(int)gridDim.x, (int)blockIdx.x, layer0};
            pg8::EpiFfn2 E{O1};
            pg8::gemm_phase<pg8::EpiFfn2, pg8::OrderFfn2>(lds, g, S, E, nullptr);
            if (gridDim.x == 256 && layer0 && blockIdx.x >= 128) { int ln = lane; asm volatile("" : "+v"(ln)); int wv = wave; asm volatile("" : "+s"(wv)); conv_range(a, lds, wv, ln, CONV_NB, CONV_NC, blockIdx.x - 128, 128); }
        } SEAM(pb + L_FFN2);
        if (IN(pb + L_LN2)) { KARGS(); int ln = lane; asm volatile("" : "+v"(ln)); phase_ln2(a, l, layer0 ? NROW : NLAT, wave, ln); }
        if (l == 0) SEAM(pb + L_LN2);
    }
#undef IN
#undef SEAM
}
extern "C" void kernel_launch(void* const* d_in, const int* in_sizes, int n_in, void* d_out, int out_size, void* d_ws, size_t ws_size, hipStream_t stream) {
  static int grid = 0;
  if (grid == 0) {
    int dev = 0, cus = 0;
    if (hipGetDevice(&dev) != hipSuccess || hipDeviceGetAttribute(&cus, hipDeviceAttributeMultiprocessorCount, dev) != hipSuccess) { fprintf(stderr, "device query failed\n"); grid = -1; return; }
    if (hipFuncSetAttribute((const void*)mega, hipFuncAttributeMaxDynamicSharedMemorySize, LDS_BYTES) != hipSuccess) { fprintf(stderr, "hipFuncSetAttribute(mega) failed\n"); grid = -1; return; }
    grid = cus;
  }
  if (grid < 0) return;
  Args a{};
  a.x = (const float*)d_in[0]; a.c = (const float*)d_in[1]; a.ctx = (const float*)d_in[2]; a.c_ctx = (const float*)d_in[3];
  a.w_ada = (const float*)d_in[4]; a.b_ada = (const float*)d_in[5]; a.w_in = (const float*)d_in[6]; a.w_out = (const float*)d_in[7];
  a.gla_w_up = (const float*)d_in[8]; a.gla_b_up = (const float*)d_in[9]; a.gla_norm = (const float*)d_in[10];
  a.gdn_conv = (const float*)d_in[11]; a.gdn_a_log = (const float*)d_in[12]; a.gdn_dt_bias = (const float*)d_in[13]; a.gdn_norm = (const float*)d_in[14];
  a.attn_qk_norm = (const float*)d_in[15]; a.ln_gain = (const float*)d_in[16]; a.ln_bias = (const float*)d_in[17];
  a.router = (const float*)d_in[18]; a.w1 = (const float*)d_in[19]; a.w3 = (const float*)d_in[20]; a.w2 = (const float*)d_in[21];
  a.out = (float*)d_out;
  unsigned char* wsb = (unsigned char*)d_ws; size_t off = 0;
  auto take = [&](size_t bytes) { unsigned char* p = wsb + off; off += (bytes + 255) / 256 * 256; return p; };
  a.ctl = (unsigned*)take(CTL_ZERO_BYTES);
  a.MOD = (float*)take((size_t)2 * 3 * NMOD * DM * 4);
  a.WinT = (bf16_t*)take(2 * WINT_L * 2); a.WoutT = (bf16_t*)take(2 * WOUTT_L * 2); a.W13T = (bf16_t*)take(2 * W13T_L * 2); a.W2T = (bf16_t*)take(2 * W2T_L * 2);
  a.X = (float*)take((size_t)NROW * DM * 4); a.HB = (bf16_t*)take((size_t)NROW * DM * 2); a.P = (bf16_t*)take((size_t)NROW * PW * 2); a.PG = (float*)take((size_t)NROW * 64 * 4);
  a.Y = (float*)take((size_t)NROW * DM * 4); a.MIXB = (bf16_t*)take((size_t)NROW * DM * 2);
  a.XS = (bf16_t*)take((size_t)XSROWS * DM * 2); a.HM = (bf16_t*)take((size_t)XSROWS * DM * 2); a.YE = (bf16_t*)take((size_t)XSROWS * DM * 2);
  a.ROPE = (float*)take((size_t)SEQ * 128 * 4); a.AFF = (float*)take((size_t)NROW * NEXP * 4); a.AFFT = (float*)take((size_t)NROW * NEXP * 4); a.SEL = (int*)take((size_t)NROW * NEXP * 4);
  a.QB = (bf16_t*)take((size_t)NROW * 1024 * 2); a.KB = (bf16_t*)take((size_t)NB * NKEY * 256 * 2); a.VB = (bf16_t*)take((size_t)NB * NKEY * 256 * 2);
  a.GQKV = (bf16_t*)take((size_t)NROW * 1536 * 2); a.BETA = (float*)take((size_t)2 * NROW * 4 * 4); a.GG = (float*)take((size_t)2 * NROW * 4 * 4);
  a.GKV = (float*)take((size_t)16 * NCH * 8192 * 4); a.GDL = (float*)take((size_t)16 * NCH * 64 * 4); a.GST = (bf16_t*)take((size_t)16 * NCH * 8192 * 2);
  a.WG = (bf16_t*)take((size_t)16 * NCH * 8192 * 2); a.KDTG = (bf16_t*)take((size_t)16 * NCH * 8192 * 2); a.QDG = (bf16_t*)take((size_t)16 * NCH * 8192 * 2); a.AIG = (bf16_t*)take((size_t)16 * NCH * 4096 * 2);
  a.SPREV = (bf16_t*)take((size_t)16 * NCH * 16384 * 2); a.VNEW = (bf16_t*)take((size_t)16 * NCH * 8192 * 2); a.UG = (float*)take((size_t)16 * NCH * 8192 * 4); a.DLASTG = (float*)take((size_t)16 * NCH * 4);
  if (off > ws_size) { fprintf(stderr, "ws too small: need %zu have %zu\n", off, ws_size); return; }
  if (hipMemsetAsync(a.ctl, 0, CTL_ZERO_BYTES, stream) != hipSuccess) { fprintf(stderr, "memset failed\n"); return; }
  int li = 0;
  auto run = [&](int lo, int hi) { a.ph_lo = lo; a.ph_hi = hi; a.li = li++; a.pad = 0; hipLaunchKernelGGL(mega, dim3(grid), dim3(NWAVES * 64), LDS_BYTES, stream, a);
    const hipError_t le = hipPeekAtLastError(); if (le != hipSuccess) fprintf(stderr, "mega launch [%d,%d) failed: %s\n", lo, hi, hipGetErrorName(le)); };

  run(0, NPH);
}
```

```cpp
#include <hip/hip_runtime.h>
#include <stdint.h>
#include <stdio.h>

#define DM 2048
#define NB 2
#define SEQ 4096
#define CTX 256
#define NLAT (NB * SEQ)
#define NCTX (NB * CTX)
#define NROW (NLAT + NCTX)
#define INW 5168
#define PW 5120
#define NINP 5376
#define NMOD 6
#define NEXP 16
#define EFF 2048
#define CAP_L 512
#define CAP_C 32
#define XSROWS 20480
#define C_GLA_Q 0
#define C_GLA_K 256
#define C_GLA_V 512
#define C_GLA_G 1024
#define C_GLA_R 1536
#define C_GDN_Q 1568
#define C_GDN_Z 3104
#define C_GDN_B 3616
#define C_GDN_A 3624
#define C_ATT_Q 3632
#define C_ATT_K 4656
#define C_ATT_V 4912

typedef unsigned short bf16_t;
__device__ __forceinline__ float silu_f(float x) { return x * __builtin_amdgcn_rcpf(1.f + __expf(-x)); }
__device__ __forceinline__ float sigmoid_f(float x) { return __builtin_amdgcn_rcpf(1.f + __expf(-x)); }
__device__ __forceinline__ float softplus_f(float x) { return fmaxf(x, 0.f) + log1pf(__expf(-fabsf(x))); }
__device__ __forceinline__ float logsigmoid_f(float x) { return fminf(x, 0.f) - __logf(1.f + __expf(-fabsf(x))); }
__device__ __forceinline__ int stream_of_row(int r) { return r < SEQ ? 0 : (r < NLAT ? 1 : 2); }
__device__ __forceinline__ float wave_sum(float v) {
#define WS_DPP(CTRL, RMASK) __builtin_bit_cast(float, __builtin_amdgcn_update_dpp(0, __builtin_bit_cast(int, v), CTRL, RMASK, 0xF, false))
  v += WS_DPP(0xB1, 0xF); v += WS_DPP(0x4E, 0xF); v += WS_DPP(0x141, 0xF); v += WS_DPP(0x140, 0xF);
  v += WS_DPP(0x142, 0xA); v += WS_DPP(0x143, 0xC);
#undef WS_DPP
  return __builtin_bit_cast(float, __builtin_amdgcn_readlane(__builtin_bit_cast(int, v), 63));
}
typedef float f32x2c __attribute__((ext_vector_type(2)));
typedef __bf16 bf16x2c __attribute__((ext_vector_type(2)));
__device__ __forceinline__ unsigned pk2(float lo, float hi) { const f32x2c v = {lo, hi}; return __builtin_bit_cast(unsigned, __builtin_convertvector(v, bf16x2c)); }
__device__ __forceinline__ unsigned f2bf(float f) { return pk2(f, 0.f) & 0xffffu; }
__device__ __forceinline__ float bf2f(bf16_t b) { return __builtin_bit_cast(float, ((unsigned)b) << 16); }
__device__ __forceinline__ float Pget(const bf16_t* P, const float* PG, long r, int oc) {
  int nc;
  if (oc < 1536) nc = oc; else if (oc < 1568) return PG[r * 64 + (oc - 1536)]; else if (oc < 3616) nc = oc - 32;
  else if (oc < 3632) return PG[r * 64 + 32 + (oc - 3616)]; else nc = oc - 48;
  return bf2f(P[r * PW + nc]);
}
namespace pg8 {
#define PG8_LAS __attribute__((address_space(3)))
typedef unsigned short bf16_t;
typedef short bf16x8 __attribute__((ext_vector_type(8)));
typedef float f32x4 __attribute__((ext_vector_type(4)));
typedef unsigned u32x4 __attribute__((ext_vector_type(4)));
constexpr int BM = 256, BK = 64, HALF = 128, HTB = HALF * BK * 2  , STAGE_BYTES = 8 * HTB, NXCD = 8, WGM = 8;

__host__ __device__ __forceinline__ int lds_byte(int r, int c) { const int st = (r >> 4) * 2 + (c >> 5), rr = r & 15, cc = c & 31, ob = rr * 64 + cc * 2; return st * 1024 + (ob ^ (((ob >> 9) & 1) << 5)); }
__host__ __device__ __forceinline__ void stage_rc(int b, int& R, int& C) { const int st = b / 1024, sb = b % 1024, swz = sb ^ (((sb >> 9) & 1) << 5); R = (st >> 1) * 16 + swz / 64; C = (st & 1) * 32 + (swz % 64) / 2; }
__host__ __device__ __forceinline__ int perm32(int rho) { const int n = rho >> 4, i = rho & 15; return 8 * (i >> 2) + 4 * n + (i & 3); }

struct Unit { int pm, pn; };
struct Gemm { const bf16_t* A; const bf16_t* Bt; int M, N, K; };

struct StaticOrder {
    int nM, nN, nwg, G, c;
    __host__ __device__ void init(int M, int N, int G_, int c_) { nM = M / BM; nN = N / BM; nwg = nM * nN; G = G_; c = c_; }
    __host__ __device__ bool next(int i, Unit& u) const {
        const long L = (long)i * G + c; if (L >= nwg) return false;
        int wgid = (int)L; { const int q = nwg / NXCD, r = nwg % NXCD, xcd = wgid % NXCD, off = wgid / NXCD; wgid = (xcd < r ? xcd * (q + 1) : r * (q + 1) + (xcd - r) * q) + off; }
        const int nig = WGM * nN, gid = wgid / nig, fm = gid * WGM, gsz = (nM - fm) < WGM ? (nM - fm) : WGM;
        u.pm = fm + ((wgid % nig) % gsz); u.pn = (wgid % nig) / gsz; return true;
    }
    __device__ __forceinline__ void a_ready(const Unit&) const {}
    __device__ __forceinline__ void done(const Unit&) const {}
};
__device__ __forceinline__ unsigned cvt_pk_bf16(float lo, float hi) { return pk2(lo, hi); }
typedef float f32x2 __attribute__((ext_vector_type(2)));
struct EpiF32 {
    static constexpr bool PERM = false, AFTER_DRAIN = false;
    float* C; int ldc; const float* bias;
    __device__ __forceinline__ void operator()(const f32x4 (&acc)[2][2][4][2], const Unit& u, int wr, int wc, int fr, int fq) const {
        const int row0 = u.pm * BM + wr * 64 + fr, col0 = u.pn * BM + wc * 32 + 4 * fq;
        f32x4 bv[2][2];
#pragma unroll
        for (int bj = 0; bj < 2; ++bj)
#pragma unroll
            for (int n = 0; n < 2; ++n) bv[bj][n] = bias ? *(const f32x4*)(bias + col0 + bj * HALF + n * 16) : (f32x4){0.f, 0.f, 0.f, 0.f};
#pragma unroll
        for (int ai = 0; ai < 2; ++ai)
#pragma unroll
            for (int m = 0; m < 4; ++m) { float* rowp = C + (size_t)(row0 + ai * HALF + m * 16) * ldc + col0;
#pragma unroll
                for (int bj = 0; bj < 2; ++bj)
#pragma unroll
                    for (int n = 0; n < 2; ++n) *(f32x4*)(rowp + bj * HALF + n * 16) = acc[ai][bj][m][n] + bv[bj][n]; }
    }
};
struct EpiInProj {
    static constexpr bool PERM = true, AFTER_DRAIN = false;
    bf16_t* P; float* PG;
    __device__ __forceinline__ void operator()(const f32x4 (&acc)[2][2][4][2], const Unit& u, int wr, int wc, int fr, int fq) const {
        const int row0 = u.pm * BM + wr * 64 + fr;
        if (u.pn < 20) {
            const int col0 = u.pn * BM + wc * 32 + 8 * fq;
#pragma unroll
            for (int ai = 0; ai < 2; ++ai)
#pragma unroll
                for (int m = 0; m < 4; ++m) { bf16_t* rowp = P + (size_t)(row0 + ai * HALF + m * 16) * 5120 + col0;
#pragma unroll
                    for (int bj = 0; bj < 2; ++bj) { const f32x4 v0 = acc[ai][bj][m][0], v1 = acc[ai][bj][m][1];
                        u32x4 w; w.x = cvt_pk_bf16(v0[0], v0[1]); w.y = cvt_pk_bf16(v0[2], v0[3]); w.z = cvt_pk_bf16(v1[0], v1[1]); w.w = cvt_pk_bf16(v1[2], v1[3]);
                        *(u32x4*)(rowp + bj * HALF) = w; } }
        } else if (wc < 2) {
#pragma unroll
            for (int ai = 0; ai < 2; ++ai)
#pragma unroll
                for (int m = 0; m < 4; ++m) { float* rowp = PG + (size_t)(row0 + ai * HALF + m * 16) * 64 + wc * 32 + 8 * fq;
                    *(f32x4*)(rowp) = acc[ai][0][m][0]; *(f32x4*)(rowp + 4) = acc[ai][0][m][1]; }
        }
    }
};
struct EpiSwiGLU {
    static constexpr bool PERM = true, AFTER_DRAIN = false;
    bf16_t* HM;
    __device__ __forceinline__ float sg(float a, float b) const { return a * __builtin_amdgcn_rcpf(1.f + __expf(-a)) * b; }
    __device__ __forceinline__ void operator()(const f32x4 (&acc)[2][2][4][2], const Unit& u, int wr, int wc, int fr, int fq) const {
        const int row0 = u.pm * BM + wr * 64 + fr, col0 = (u.pn & 15) * HALF + wc * 32 + 8 * fq;
#pragma unroll
        for (int ai = 0; ai < 2; ++ai)
#pragma unroll
            for (int m = 0; m < 4; ++m) { bf16_t* rowp = HM + (size_t)(row0 + ai * HALF + m * 16) * 2048 + col0;
                const f32x4 a0 = acc[ai][0][m][0], a1 = acc[ai][0][m][1], b0 = acc[ai][1][m][0], b1 = acc[ai][1][m][1];
                u32x4 w; w.x = cvt_pk_bf16(sg(a0[0], b0[0]), sg(a0[1], b0[1])); w.y = cvt_pk_bf16(sg(a0[2], b0[2]), sg(a0[3], b0[3]));
                w.z = cvt_pk_bf16(sg(a1[0], b1[0]), sg(a1[1], b1[1])); w.w = cvt_pk_bf16(sg(a1[2], b1[2]), sg(a1[3], b1[3]));
                *(u32x4*)(rowp) = w; }
    }
};
struct EpiFfn2 {
    static constexpr bool PERM = true, AFTER_DRAIN = false;
    bf16_t* YE;
    __device__ __forceinline__ void operator()(const f32x4 (&acc)[2][2][4][2], const Unit& u, int wr, int wc, int fr, int fq) const {
        const int row0 = u.pm * BM + wr * 64 + fr, col0 = (u.pn & 7) * BM + wc * 32 + 8 * fq;
#pragma unroll
        for (int ai = 0; ai < 2; ++ai)
#pragma unroll
            for (int m = 0; m < 4; ++m) { bf16_t* rowp = YE + (size_t)(row0 + ai * HALF + m * 16) * 2048 + col0;
#pragma unroll
                for (int bj = 0; bj < 2; ++bj) { const f32x4 v0 = acc[ai][bj][m][0], v1 = acc[ai][bj][m][1];
                    u32x4 w; w.x = cvt_pk_bf16(v0[0], v0[1]); w.y = cvt_pk_bf16(v0[2], v0[3]); w.z = cvt_pk_bf16(v1[0], v1[1]); w.w = cvt_pk_bf16(v1[2], v1[3]);
                    *(u32x4*)(rowp + bj * HALF) = w; } }
    }
};
struct OrderFfn1 {
    int G, c, layer0;
    __device__ __forceinline__ bool next(int i, Unit& u) const {
        const long L = (long)i * G + c; const int total = layer0 ? 1280 : 1024; if (L >= total) return false;
        const int r = (int)(L >> 8), cc = (int)(L & 255), xcd = cc & 7, w = cc >> 3;
        if (r < 4) { const int e = 4 * r + (xcd >> 1), ii = w & 3, j = (xcd & 1) * 8 + (w >> 2); u.pm = e * 4 + ii; u.pn = e * 16 + j; }
        else { const int e = 2 * xcd + (w >> 4), j = w & 15; u.pm = 64 + e; u.pn = e * 16 + j; }
        return true; }
    __device__ __forceinline__ void a_ready(const Unit&) const {}
    __device__ __forceinline__ void done(const Unit&) const {}
};
struct OrderFfn2 {
    int G, c, layer0;
    __device__ __forceinline__ bool next(int i, Unit& u) const {
        const long L = (long)i * G + c; const int total = layer0 ? 640 : 512; if (L >= total) return false;
        const int r = (int)(L >> 8), cc = (int)(L & 255), xcd = cc & 7, w = cc >> 3;
        if (r < 2) { const int e = 8 * r + xcd, ii = w & 3, j = w >> 2; u.pm = e * 4 + ii; u.pn = e * 8 + j; }
        else { const int e = 2 * xcd + (w >> 3), j = w & 7; u.pm = 64 + e; u.pn = e * 8 + j; }
        return true; }
    __device__ __forceinline__ void a_ready(const Unit&) const {}
    __device__ __forceinline__ void done(const Unit&) const {}
};
template <class Epi, class Sched, bool STAMP = false>
__device__ __forceinline__ void gemm_phase(PG8_LAS unsigned char* lds, const Gemm g, const Sched& S, const Epi& E, unsigned long long* stamps) {
    int tid_ = threadIdx.x; asm volatile("" : "+v"(tid_));
    const int tid = tid_, wid = __builtin_amdgcn_readfirstlane(tid >> 6), lane = tid & 63, wr = wid >> 2, wc = wid & 3, fr = lane & 15, fq = lane >> 4;
    const int K = g.K, nt = K / BK;
    int ts_lo = 0, ts_hi = 0, nts = 0; const unsigned long long rt_entry = STAMP ? (unsigned long long)wall_clock64() : 0ull;
#define PG8_STAMP() do { if (STAMP && wid == 0 && nts < 64) { const unsigned long long _c = (unsigned long long)clock64(); \
        ts_lo = (lane == nts) ? (int)(unsigned)_c : ts_lo; ts_hi = (lane == nts) ? (int)(unsigned)(_c >> 32) : ts_hi; ++nts; } } while (0)
    PG8_STAMP();
    unsigned voffA[2], voffB[2];
#pragma unroll
    for (int i = 0; i < 2; ++i) { int R, C; stage_rc(tid * 16 + i * 8192, R, C); const int Rb = Epi::PERM ? ((R & ~31) + perm32(R & 31)) : R;
        voffA[i] = (unsigned)(R * K + C) * 2u; voffB[i] = (unsigned)(Rb * K + C) * 2u; }
    const size_t kstep = (size_t)(BK * 2);
    const size_t hstep = (size_t)HALF * K * 2;
    const size_t tstep = 2 * hstep;
    const unsigned ldsw = (unsigned)wid * 1024u;
    const int aoff = lds_byte(wr * 64 + fr, fq * 8), boff = lds_byte(wc * 32 + fr, fq * 8);
#define PG8_SA(b, h) (((b) * 2 + (h)) * HTB)
#define PG8_SB(b, h) ((4 + (b) * 2 + (h)) * HTB)
#define PG8_STAGE(bufoff, gbase, voff) do { _Pragma("unroll") for (int _i = 0; _i < 2; ++_i) \
        __builtin_amdgcn_global_load_lds((const unsigned*)((const char*)(gbase) + (voff)[_i]), (PG8_LAS unsigned*)(lds + (bufoff) + ldsw + _i * 8192), 16, 0, 0); } while (0)
#define PG8_LDA(dst, b, h) do { _Pragma("unroll") for (int m = 0; m < 4; ++m) _Pragma("unroll") for (int k = 0; k < 2; ++k) dst[m][k] = *(const PG8_LAS bf16x8*)(lds + PG8_SA(b, h) + aoff + m * 2048 + k * 1024); } while (0)
#define PG8_LDB(dst, b, h) do { _Pragma("unroll") for (int n = 0; n < 2; ++n) _Pragma("unroll") for (int k = 0; k < 2; ++k) dst[n][k] = *(const PG8_LAS bf16x8*)(lds + PG8_SB(b, h) + boff + n * 2048 + k * 1024); } while (0)
#define PG8_MMA(ai, bj, At, Bt) do { __builtin_amdgcn_s_setprio(1); _Pragma("unroll") for (int m = 0; m < 4; ++m) _Pragma("unroll") for (int n = 0; n < 2; ++n) _Pragma("unroll") for (int k = 0; k < 2; ++k) \
        acc[ai][bj][m][n] = __builtin_amdgcn_mfma_f32_16x16x32_bf16(Bt[n][k], At[m][k], acc[ai][bj][m][n], 0, 0, 0); __builtin_amdgcn_s_setprio(0); } while (0)
#define PG8_WAIT_V(n) asm volatile("s_waitcnt vmcnt(" #n ")" ::: "memory")
#define PG8_WAIT_L(n) asm volatile("s_waitcnt lgkmcnt(" #n ")" ::: "memory")
#define PG8_BAR __builtin_amdgcn_s_barrier()
#define PG8_SCHED __builtin_amdgcn_sched_barrier(0)
    Unit cur, nxt; int ui = 0;
    if (!S.next(0, cur)) return;
    f32x4 acc[2][2][4][2];
#pragma unroll
    for (int a = 0; a < 2; ++a)
#pragma unroll
        for (int b = 0; b < 2; ++b)
#pragma unroll
            for (int m = 0; m < 4; ++m)
#pragma unroll
                for (int n = 0; n < 2; ++n) acc[a][b][m][n] = (f32x4){0.f, 0.f, 0.f, 0.f};
    bf16x8 At[4][2], B0[2][2], B1[2][2];
    const char* cA = (const char*)g.A + (size_t)cur.pm * tstep; const char* cB = (const char*)g.Bt + (size_t)cur.pn * tstep;
    S.a_ready(cur);
    PG8_STAGE(PG8_SB(0, 0), cB, voffB); PG8_STAGE(PG8_SA(0, 0), cA, voffA); PG8_STAGE(PG8_SB(0, 1), cB + hstep, voffB); PG8_STAGE(PG8_SA(0, 1), cA + hstep, voffA);
    if (wr == 1) PG8_BAR;
    PG8_WAIT_V(4); PG8_BAR;
    PG8_STAGE(PG8_SB(1, 0), cB + kstep, voffB); PG8_STAGE(PG8_SA(1, 0), cA + kstep, voffA); PG8_STAGE(PG8_SB(1, 1), cB + hstep + kstep, voffB);
    PG8_WAIT_V(6); PG8_BAR;
    PG8_STAMP();
    for (;;) {
        const bool has_next = S.next(ui + 1, nxt);
        const char* nA = has_next ? (const char*)g.A + (size_t)nxt.pm * tstep : cA; const char* nB = has_next ? (const char*)g.Bt + (size_t)nxt.pn * tstep : cB;
        for (int t = 0; t < nt; t += 2) {
            const bool last = (t == nt - 2);
            const char* a1 = cA + (size_t)(t + 1) * kstep;
            const char* a2 = last ? nA : cA + (size_t)(t + 2) * kstep; const char* b2 = last ? nB : cB + (size_t)(t + 2) * kstep;
            const char* a3 = a2 + kstep; const char* b3 = b2 + kstep;
            if (last && has_next) S.a_ready(nxt);
            PG8_LDB(B0, 0, 0); PG8_SCHED; PG8_LDA(At, 0, 0); PG8_STAGE(PG8_SA(1, 1), a1 + hstep, voffA);
            PG8_WAIT_L(8); PG8_BAR; PG8_WAIT_L(0); PG8_MMA(0, 0, At, B0); PG8_BAR; PG8_SCHED;
            PG8_LDB(B1, 0, 1); PG8_STAGE(PG8_SB(0, 0), b2, voffB);
            PG8_BAR; PG8_WAIT_L(0); PG8_MMA(0, 1, At, B1); PG8_BAR;
            PG8_LDA(At, 0, 1); PG8_STAGE(PG8_SA(0, 0), a2, voffA);
            PG8_BAR; PG8_WAIT_L(0); PG8_MMA(1, 0, At, B0); PG8_BAR; PG8_SCHED;
            PG8_STAGE(PG8_SB(0, 1), b2 + hstep, voffB);
            PG8_WAIT_V(6); PG8_BAR; PG8_MMA(1, 1, At, B1); PG8_BAR;
            PG8_LDB(B0, 1, 0); PG8_SCHED; PG8_LDA(At, 1, 0); PG8_STAGE(PG8_SA(0, 1), a2 + hstep, voffA);
            PG8_WAIT_L(8); PG8_BAR; PG8_WAIT_L(0); PG8_MMA(0, 0, At, B0); PG8_BAR; PG8_SCHED;
            PG8_LDB(B1, 1, 1); PG8_STAGE(PG8_SB(1, 0), b3, voffB);
            PG8_BAR; PG8_WAIT_L(0); PG8_MMA(0, 1, At, B1); PG8_BAR;
            PG8_LDA(At, 1, 1); PG8_STAGE(PG8_SA(1, 0), a3, voffA);
            PG8_BAR; PG8_WAIT_L(0); PG8_MMA(1, 0, At, B0); PG8_BAR; PG8_SCHED;
            PG8_STAGE(PG8_SB(1, 1), b3 + hstep, voffB);
            PG8_WAIT_V(6); PG8_BAR; PG8_MMA(1, 1, At, B1); PG8_BAR;
        }
        PG8_STAMP();
        if constexpr (!Epi::AFTER_DRAIN) { E(acc, cur, wr, wc, fr, fq); S.done(cur); }
        PG8_STAMP();
        if (!has_next) break;
#pragma unroll
        for (int a = 0; a < 2; ++a)
#pragma unroll
            for (int b = 0; b < 2; ++b)
#pragma unroll
                for (int m = 0; m < 4; ++m)
#pragma unroll
                    for (int n = 0; n < 2; ++n) acc[a][b][m][n] = (f32x4){0.f, 0.f, 0.f, 0.f};
        cur = nxt; cA = nA; cB = nB; ++ui;
    }
    PG8_WAIT_V(0);
    if (wr == 0) PG8_BAR;
    PG8_BAR;
    if constexpr (Epi::AFTER_DRAIN) { E.fused(acc, cur, wr, wc, fr, fq, lds, wid, lane); S.done(cur); }
    PG8_STAMP();
    if (STAMP && wid == 0) { stamps[lane] = lane < nts ? (((unsigned long long)(unsigned)ts_hi << 32) | (unsigned)ts_lo) : 0ull;
        if (lane == 62) stamps[62] = rt_entry; if (lane == 63) stamps[63] = (unsigned long long)wall_clock64(); }
#undef PG8_STAMP
#undef PG8_SA
#undef PG8_SB
#undef PG8_STAGE
#undef PG8_LDA
#undef PG8_LDB
#undef PG8_MMA
#undef PG8_WAIT_V
#undef PG8_WAIT_L
#undef PG8_BAR
#undef PG8_SCHED
}
}
#define XB_TMO      128
#define XB_XCNT(j)  (256  + 64 * (j))
#define XB_XSUB(j)  (1280 + 64 * (j))
#define XB_XGEN(j)  (2304 + 64 * (j))
#define XB_TOP      3328
#define XB_TOPGEN   3392
#define XCD_BAR_WORDS 3456
#define XB_SPIN_CAP (1u << 18)
#define LAS __attribute__((address_space(3)))

__device__ __forceinline__ unsigned xb_ld(unsigned* p)              { return __hip_atomic_load(p, __ATOMIC_RELAXED, __HIP_MEMORY_SCOPE_AGENT); }
__device__ __forceinline__ unsigned xb_add(unsigned* p, unsigned v) { return __hip_atomic_fetch_add(p, v, __ATOMIC_RELAXED, __HIP_MEMORY_SCOPE_AGENT); }
__device__ __forceinline__ unsigned xb_xcc_id() { return (unsigned)__builtin_amdgcn_s_getreg((3 << 11) | 20) & 0xFu; }
#define XB_SPIN(cond, bar) do { unsigned _sp = 0; while (cond) { __builtin_amdgcn_s_sleep(1); \
    if ((++_sp & 255u) == 0u) { if (xb_ld(&(bar)[XB_TMO])) break; if (_sp > XB_SPIN_CAP) { atomicAdd(&(bar)[XB_TMO], 1u); break; } } } } while (0)

struct XcdBarrier {
    unsigned* bar; unsigned x;
    volatile LAS unsigned* st;
};

__device__ __forceinline__ XcdBarrier xcd_barrier_post(unsigned* bar, volatile LAS unsigned* st) {
    XcdBarrier b; b.bar = bar; b.x = xb_xcc_id(); b.st = st;
    if (threadIdx.x == 0) (void)xb_add(&bar[XB_XCNT(b.x)], 1u);
    return b;
}
__device__ __forceinline__ void xcd_barrier_complete(unsigned* bar, unsigned x, unsigned& nloc, unsigned& nx) {
    const unsigned G = gridDim.x * gridDim.y * gridDim.z;
    unsigned sum, cnt, mine, sp = 0u;
    for (;;) {
        sum = 0u; cnt = 0u; mine = 0u;
#pragma unroll
        for (unsigned j = 0; j < 16; ++j) { const unsigned c = xb_ld(&bar[XB_XCNT(j)]); sum += c; cnt += (c > 0u) ? 1u : 0u; mine = (j == x) ? c : mine; }
        if (sum == G) break;
        __builtin_amdgcn_s_sleep(1);
        if ((++sp & 255u) == 0u) { if (xb_ld(&bar[XB_TMO])) break; if (sp > XB_SPIN_CAP) { atomicAdd(&bar[XB_TMO], 1u); break; } }
    }
    nloc = mine > 0u ? mine : 1u; nx = cnt > 0u ? cnt : 1u;
}

__device__ __forceinline__ void xcd_barrier(const XcdBarrier& b) {
    asm volatile("s_waitcnt vmcnt(0)" ::: "memory");
    __syncthreads();
    if (threadIdx.x == 0) {
        unsigned* bar = b.bar;
        __builtin_amdgcn_s_waitcnt(0);
        unsigned nloc = b.st[0], nx = b.st[1];
        if (nloc == 0u) { xcd_barrier_complete(bar, b.x, nloc, nx); b.st[0] = nloc; b.st[1] = nx; }
        const unsigned old = xb_add(&bar[XB_XSUB(b.x)], 1u);
        const unsigned gen = old / nloc;
        if (old + 1u == (gen + 1u) * nloc) {
            __builtin_amdgcn_fence(__ATOMIC_RELEASE, "agent");
            asm volatile("s_waitcnt vmcnt(0)" ::: "memory");
            const unsigned og = xb_add(&bar[XB_TOP], 1u);
            const unsigned tg = og / nx;
            if (og + 1u == (tg + 1u) * nx) xb_add(&bar[XB_TOPGEN], 1u);
            else XB_SPIN(xb_ld(&bar[XB_TOPGEN]) == tg, bar);
            __builtin_amdgcn_fence(__ATOMIC_ACQUIRE, "agent");
            xb_add(&bar[XB_XGEN(b.x)], 1u);
            asm volatile("s_waitcnt vmcnt(0)" ::: "memory");
        } else {
            XB_SPIN(xb_ld(&bar[XB_XGEN(b.x)]) == gen, bar);
            __builtin_amdgcn_fence(__ATOMIC_ACQUIRE, "agent");
            asm volatile("s_waitcnt vmcnt(0)" ::: "memory");
        }
    }
    __syncthreads();
}
#define LAS __attribute__((address_space(3)))
#define GAS __attribute__((address_space(1)))
typedef unsigned v4u __attribute__((ext_vector_type(4)));
#define LDS_WAIT() asm volatile("s_waitcnt lgkmcnt(0)" ::: "memory")
#define VM_WAIT() asm volatile("s_waitcnt vmcnt(0)" ::: "memory")
#define LDS_BAR() do { asm volatile("s_waitcnt lgkmcnt(0)" ::: "memory"); __builtin_amdgcn_s_barrier(); asm volatile("" ::: "memory"); } while (0)
constexpr int RING_BYTES = 131072, LDSCTL_OFF = RING_BYTES, MISC_OFF = LDSCTL_OFF + 320, LDS_BYTES = 147456, NWAVES = 8;
constexpr int CW_BAR = 4096;
constexpr size_t CTL_ZERO_BYTES = 1u << 20;
constexpr int NPH_PRO = 2, NPH_LAYER = 11, NPH = NPH_PRO + 2 * NPH_LAYER;
enum { PH_CONV = 0, PH_INIT = 1, L_INPROJ = 0, L_PREP = 1, L_CHUNK = 2, L_SCAN = 3, L_OUT = 4, L_OPROJ = 5, L_LN1 = 6, L_TOPK = 7, L_FFN1 = 8, L_FFN2 = 9, L_LN2 = 10 };

struct Args {
    const float *x, *c, *ctx, *c_ctx, *w_ada, *b_ada, *w_in, *w_out, *gla_w_up, *gla_b_up, *gla_norm, *gdn_conv, *gdn_a_log, *gdn_dt_bias, *gdn_norm,
                *attn_qk_norm, *ln_gain, *ln_bias, *router, *w1, *w3, *w2;
    float* out; unsigned* ctl; float* MOD;
    bf16_t *WinT, *WoutT, *W13T, *W2T;
    float* X; bf16_t* HB; bf16_t* P; float* PG; float* Y; bf16_t* MIXB; bf16_t *XS, *HM, *YE;
    float *ROPE, *AFF, *AFFT; int* SEL;
    bf16_t *QB, *KB, *VB, *GQKV; float *BETA, *GG;
    float *GKV, *GDL; bf16_t* GST;
    bf16_t *WG, *KDTG, *QDG, *AIG, *SPREV, *VNEW; float *UG, *DLASTG;
    int ph_lo, ph_hi, li, pad;
};
typedef const __attribute__((address_space(4))) Args* KA;
constexpr size_t WINT_L = (size_t)NINP * DM, WOUTT_L = (size_t)DM * DM, W13T_L = (size_t)NEXP * 4096 * DM, W2T_L = (size_t)NEXP * DM * EFF;

__device__ __forceinline__ void transpose_item(const float* src, int ldn, int nvalid, bf16_t* dst, int K, int k0, LAS float* scr, int lane) {
    const int x = lane & 31; const bool ok = x < nvalid;
#pragma unroll 8
    for (int i = 0; i < 32; ++i) { const int kk = 2 * i + (lane >> 5); scr[kk * 33 + x] = ok ? src[(size_t)(k0 + kk) * ldn + x] : 0.f; }
    LDS_WAIT(); asm volatile("" ::: "memory");
    const int c = lane & 7;
#pragma unroll
    for (int j = 0; j < 4; ++j) { const int n = (lane >> 3) + 8 * j; const LAS float* s = scr + (8 * c) * 33 + n;
        v4u o; o.x = pk2(s[0 * 33], s[1 * 33]); o.y = pk2(s[2 * 33], s[3 * 33]); o.z = pk2(s[4 * 33], s[5 * 33]); o.w = pk2(s[6 * 33], s[7 * 33]);
        *(GAS v4u*)(dst + (size_t)n * K + k0 + 8 * c) = o; }
    LDS_WAIT(); asm volatile("" ::: "memory");
}
typedef float f32x4v __attribute__((ext_vector_type(4)));
constexpr int CV_IN = 32 * (NINP / 64), CV_OUT = 32 * (DM / 64), CV_13 = 32 * (NEXP * 4096 / 64), CV_2 = 32 * (NEXP * DM / 64), CV_L = CV_IN + CV_OUT + CV_13 + CV_2;
constexpr int CONV_NALL = 2 * CV_L;
constexpr int CONV_QA = 14000, CONV_QB = 7000, CONV_QC = 4000, CONV_QE = 14000;
constexpr int CONV_N0 = CONV_NALL - CONV_QA - CONV_QB - CONV_QC - CONV_QE, CONV_NA = CONV_N0 + CONV_QA, CONV_NB = CONV_NA + CONV_QB, CONV_NC = CONV_NB + CONV_QC;
__device__ __forceinline__ int in_src_col(int np) {
    if (np < 1536) return np; if (np < 3584) return np + 32; if (np < 5120) return np + 48; if (np < 5152) return 1536 + (np - 5120); if (np < 5168) return 3616 + (np - 5152); return -1;
}
__device__ __forceinline__ void conv_range(KA a, LAS unsigned char* lds, int wave, int lane, int it_begin, int it_end, int widx, int nw) {
    LAS float* tile = (LAS float*)(lds + wave * 16384);
    const int gw = widx * NWAVES + wave, NGW = nw * NWAVES;
    const int kq = lane >> 4, n4 = (lane & 15) * 4;
#define CONV_DECODE(it_, SRC, DST, LDN, KK, K0) do { const int l_ = (it_) / CV_L; int r_ = (it_) % CV_L; \
        if (r_ < CV_IN) { const int db = r_ >> 5, kb = r_ & 31; const int sc_ = in_src_col(64 * db + n4); \
            SRC = sc_ >= 0 ? a->w_in + (size_t)l_ * DM * INW + sc_ : (const float*)nullptr; LDN = INW; DST = a->WinT + l_ * WINT_L + (size_t)(64 * db) * DM; KK = DM; K0 = 64 * kb; } \
        else if ((r_ -= CV_IN) < CV_OUT) { const int db = r_ >> 5, kb = r_ & 31; \
            SRC = a->w_out + (size_t)l_ * DM * DM + 64 * db + n4; LDN = DM; DST = a->WoutT + l_ * WOUTT_L + (size_t)(64 * db) * DM; KK = DM; K0 = 64 * kb; } \
        else if ((r_ -= CV_OUT) < CV_13) { const int db = r_ >> 5, kb = r_ & 31, e = db >> 6, q = db & 63, j = q >> 2, bj = (q >> 1) & 1, xb = q & 1; \
            SRC = (bj ? a->w3 : a->w1) + ((size_t)l_ * NEXP + e) * DM * EFF + 128 * j + 64 * xb + n4; LDN = EFF; DST = a->W13T + l_ * W13T_L + (size_t)(64 * db) * DM; KK = DM; K0 = 64 * kb; } \
        else { r_ -= CV_13; const int db = r_ >> 5, kb = r_ & 31, e = db >> 5, nb = db & 31; \
            SRC = a->w2 + ((size_t)l_ * NEXP + e) * EFF * DM + 64 * nb + n4; LDN = DM; DST = a->W2T + l_ * W2T_L + (size_t)(64 * db) * EFF; KK = EFF; K0 = 64 * kb; } } while (0)
#define CONV_LOAD(R, SRC, LDN, K0) do { const float* p_ = (SRC) ? (SRC) + (size_t)((K0) + kq) * (LDN) : (const float*)nullptr; \
        _Pragma("unroll") for (int i = 0; i < 16; ++i) R[i] = p_ ? __builtin_nontemporal_load((const f32x4v*)(p_ + (size_t)(4 * i) * (LDN))) : (f32x4v){0.f, 0.f, 0.f, 0.f}; } while (0)
    int it = it_begin + gw;
    if (it < it_end) {
        const float* src; bf16_t* dst; int ldn, KK, k0; f32x4v r[16];
        CONV_DECODE(it, src, dst, ldn, KK, k0); CONV_LOAD(r, src, ldn, k0);
        for (;;) {
            const int nit = it + NGW; const bool more = nit < it_end;
            const float* nsrc = src; bf16_t* ndst = dst; int nldn = ldn, nKK = KK, nk0 = k0; f32x4v rn[16];
            if (more) { CONV_DECODE(nit, nsrc, ndst, nldn, nKK, nk0); CONV_LOAD(rn, nsrc, nldn, nk0); }
#pragma unroll
            for (int i = 0; i < 16; ++i) { const int kk = 4 * i + kq; *(LAS f32x4v*)(tile + kk * 64 + ((((lane & 15)) ^ ((kk >> 3) & 7)) << 2)) = r[i]; }
            LDS_WAIT(); asm volatile("" ::: "memory");
            { const int kc = lane & 7;
#pragma unroll
              for (int j = 0; j < 8; ++j) { const int n = (lane >> 3) + 8 * j; const LAS float* sp = tile + (8 * kc) * 64 + ((((n >> 2)) ^ kc) << 2) + (n & 3);
                  v4u o; o.x = pk2(sp[0 * 64], sp[1 * 64]); o.y = pk2(sp[2 * 64], sp[3 * 64]); o.z = pk2(sp[4 * 64], sp[5 * 64]); o.w = pk2(sp[6 * 64], sp[7 * 64]);
                  __builtin_nontemporal_store(o, (GAS v4u*)(dst + (size_t)n * KK + k0 + 8 * kc)); } }
            LDS_WAIT(); asm volatile("" ::: "memory");
            if (!more) break;
            it = nit; src = nsrc; dst = ndst; ldn = nldn; KK = nKK; k0 = nk0;
#pragma unroll
            for (int i = 0; i < 16; ++i) r[i] = rn[i];
        }
    }
#undef CONV_DECODE
#undef CONV_LOAD
}
__device__ __forceinline__ void phase_convert(KA a, LAS unsigned char* lds, int wave, int lane) {
    { LAS float* sv = (LAS float*)lds; LAS float* part = sv + 3 * DM;
      const int tid = wave * 64 + lane, n = tid & 127, kg = tid >> 7;
      for (int unit = blockIdx.x; unit < 2 * 96; unit += gridDim.x) {
        const int l = unit / 96, n0 = (unit % 96) * 128;
        for (int i = tid; i < DM; i += 512) { sv[i] = silu_f(a->c[i]); sv[DM + i] = silu_f(a->c[DM + i]); sv[2 * DM + i] = silu_f(a->c_ctx[i]); }
        __syncthreads();
        const float* w = a->w_ada + (size_t)l * DM * (NMOD * DM) + n0 + n;
        float a0 = 0.f, a1 = 0.f, a2 = 0.f;
#pragma unroll 8
        for (int k = kg * 512; k < kg * 512 + 512; ++k) { const float wv = w[(size_t)k * (NMOD * DM)]; a0 += sv[k] * wv; a1 += sv[DM + k] * wv; a2 += sv[2 * DM + k] * wv; }
        part[(kg * 3 + 0) * 128 + n] = a0; part[(kg * 3 + 1) * 128 + n] = a1; part[(kg * 3 + 2) * 128 + n] = a2;
        __syncthreads();
        if (tid < 384) { const int s = tid >> 7; const float v = part[(0 * 3 + s) * 128 + n] + part[(1 * 3 + s) * 128 + n] + part[(2 * 3 + s) * 128 + n] + part[(3 * 3 + s) * 128 + n];
            a->MOD[(size_t)(l * 3 + s) * (NMOD * DM) + n0 + n] = v + a->b_ada[l * NMOD * DM + n0 + n]; }
        __syncthreads();
      } }
    conv_range(a, lds, wave, lane, 0, (gridDim.x == 256) ? CONV_N0 : CONV_NALL, blockIdx.x, gridDim.x);
}

typedef float f32x4v __attribute__((ext_vector_type(4)));
#define ALPHA_DN 1.4142135623730951f
__device__ __forceinline__ unsigned long long pk4(f32x4v v) { return (unsigned long long)pk2(v.x, v.y) | ((unsigned long long)pk2(v.z, v.w) << 32); }

__device__ __forceinline__ void phase_init(KA a, int wave, int lane) {
    const int gw = blockIdx.x * NWAVES + wave, NGW = gridDim.x * NWAVES;
    for (int row = gw; row < NROW; row += NGW) {
        const int s = stream_of_row(row);
        const f32x4v* src = (const f32x4v*)(row < NLAT ? a->x + (size_t)row * DM : a->ctx + (size_t)(row - NLAT) * DM) + lane;
        const f32x4v* sh = (const f32x4v*)(a->MOD + (size_t)(0 * 3 + s) * (NMOD * DM)) + lane; const f32x4v* sc = sh + DM / 4;
        f32x4v* xo = (f32x4v*)(a->X + (size_t)row * DM) + lane; unsigned long long* ho = (unsigned long long*)(a->HB + (size_t)row * DM) + lane;
        f32x4v v[8], t1[8], t2[8];
#pragma unroll
        for (int i = 0; i < 8; ++i) v[i] = __builtin_nontemporal_load(src + 64 * i);
#pragma unroll
        for (int i = 0; i < 8; ++i) t1[i] = sc[64 * i];
#pragma unroll
        for (int i = 0; i < 8; ++i) t2[i] = sh[64 * i];
#pragma unroll
        for (int i = 0; i < 8; ++i) { __builtin_nontemporal_store(v[i], xo + 64 * i); const f32x4v h = v[i] * (t1[i] + 1.f) + t2[i]; ho[64 * i] = pk4(h); }
    }
    for (int i = blockIdx.x * (NWAVES * 64) + wave * 64 + lane; i < SEQ * 64; i += gridDim.x * NWAVES * 64) {
        const int t = i >> 6, f = i & 63; const float inv = powf(10000.f, -(float)(f & 31) / 32.f);
        const float ang = (float)(f < 32 ? (t >> 6) : (t & 63)) * inv;
        a->ROPE[(size_t)t * 128 + f] = cosf(ang); a->ROPE[(size_t)t * 128 + 64 + f] = sinf(ang);
    }
}

__device__ __forceinline__ void phase_ln1(KA a, int l, int nrows, LAS unsigned char* lds, int wave, int lane) {
    const int gw = blockIdx.x * NWAVES + wave, NGW = gridDim.x * NWAVES;
    const f32x4v* gn = (const f32x4v*)(a->ln_gain + (size_t)(l * 2 + 0) * DM) + lane; const f32x4v* bs = (const f32x4v*)(a->ln_bias + (size_t)(l * 2 + 0) * DM) + lane;
    LAS f32x4v* RL = (LAS f32x4v*)lds;
    { const f32x4v* rt = (const f32x4v*)(a->router + (size_t)l * DM * NEXP);
      for (int g = wave * 64 + lane; g < 8192; g += NWAVES * 64) { const int r = g >> 2, c = g & 3, i = r >> 8, q = r & 3, ln = (r >> 2) & 63; RL[((i * 4 + q) * 4 + c) * 64 + ln] = rt[g]; }
      LDS_BAR(); }
    const LAS f32x4v* RLlo = RL + lane; const LAS f32x4v* RLhi = RL + 4096 + lane;
    for (int row = gw; row < nrows; row += NGW) {
        const int s = stream_of_row(row);
        const f32x4v* md = (const f32x4v*)(a->MOD + (size_t)(l * 3 + s) * (NMOD * DM)) + lane;
        f32x4v* xp = (f32x4v*)(a->X + (size_t)row * DM) + lane; const f32x4v* yp = (const f32x4v*)(a->Y + (size_t)row * DM) + lane;
        unsigned long long* ho = (unsigned long long*)(a->HB + (size_t)row * DM) + lane;
        f32x4v v[8], ty[8], tg[8]; float sum = 0.f;
#pragma unroll
        for (int i = 0; i < 8; ++i) v[i] = __builtin_nontemporal_load(xp + 64 * i);
#pragma unroll
        for (int i = 0; i < 8; ++i) ty[i] = __builtin_nontemporal_load(yp + 64 * i);
#pragma unroll
        for (int i = 0; i < 8; ++i) tg[i] = md[2 * (DM / 4) + 64 * i];
#pragma unroll
        for (int i = 0; i < 8; ++i) { v[i] = v[i] * ALPHA_DN + tg[i] * ty[i]; sum += (v[i].x + v[i].y) + (v[i].z + v[i].w); }
        const float mean = wave_sum(sum) * (1.f / DM); float sq = 0.f;
#pragma unroll
        for (int i = 0; i < 8; ++i) { v[i] = v[i] - mean; sq += (v[i].x * v[i].x + v[i].y * v[i].y) + (v[i].z * v[i].z + v[i].w * v[i].w); }
        const float rstd = rsqrtf(wave_sum(sq) * (1.f / DM) + 1e-5f);
        f32x4v h[8];
#pragma unroll
        for (int i = 0; i < 8; ++i) ty[i] = gn[64 * i];
#pragma unroll
        for (int i = 0; i < 8; ++i) tg[i] = bs[64 * i];
#pragma unroll
        for (int i = 0; i < 8; ++i) h[i] = md[4 * (DM / 4) + 64 * i];
#pragma unroll
        for (int i = 0; i < 8; ++i) v[i] = v[i] * rstd * ty[i] + tg[i];
#pragma unroll
        for (int i = 0; i < 8; ++i) ty[i] = md[3 * (DM / 4) + 64 * i];
#pragma unroll
        for (int i = 0; i < 8; ++i) h[i] = v[i] * (h[i] + 1.f) + ty[i];
#pragma unroll
        for (int i = 0; i < 8; ++i) { __builtin_nontemporal_store(v[i], xp + 64 * i); ho[64 * i] = pk4(h[i]); }
        float acc[NEXP];
#pragma unroll
        for (int e = 0; e < NEXP; ++e) acc[e] = 0.f;
#pragma unroll
        for (int i = 0; i < 8; ++i) {
#pragma unroll
            for (int q = 0; q < 4; ++q) { const float hq = h[i][q];
#pragma unroll
                for (int c = 0; c < 4; ++c) { const f32x4v w = (i < 4 ? RLlo : RLhi)[(((i & 3) * 4 + q) * 4 + c) * 64]; acc[c * 4 + 0] += hq * w.x;     acc[c * 4 + 1] += hq * w.y; acc[c * 4 + 2] += hq * w.z; acc[c * 4 + 3] += hq * w.w; } }
            asm volatile("" ::: "memory");
        }
        float m = -1e30f;
#pragma unroll
        for (int e = 0; e < NEXP; ++e) { acc[e] = wave_sum(acc[e]); m = fmaxf(m, acc[e]); }
        float ssum = 0.f;
#pragma unroll
        for (int e = 0; e < NEXP; ++e) { acc[e] = __expf(acc[e] - m); ssum += acc[e]; }
        float mine = 0.f;
#pragma unroll
        for (int e = 0; e < NEXP; ++e) mine = (lane == e) ? acc[e] : mine;
        if (lane < NEXP) { const float af = mine / ssum; a->AFF[(size_t)row * NEXP + lane] = af; a->AFFT[(size_t)lane * NROW + row] = af; }
    }
}

__device__ __forceinline__ void phase_topk(KA a, int layer0, LAS unsigned char* lds, const int tid) {
    const int lane = tid & 63, wave = __builtin_amdgcn_readfirstlane(tid >> 6);
    LAS int* hist = (LAS int*)lds; LAS int* ctl = (LAS int*)(lds + 4096); LAS int* lst = (LAS int*)(lds + 8192); LAS int* eql = (LAS int*)(lds + 16384);
    const int nunits = layer0 ? 544 : 512;
    for (int unit = blockIdx.x; unit < nunits; unit += gridDim.x) {
        int b, e, chunk, T, cap, row0, xs_base;
        if (unit < 512) { b = unit >> 8; e = (unit >> 4) & 15; chunk = unit & 15; T = SEQ; cap = CAP_L; row0 = b * SEQ; xs_base = e * 1024 + b * CAP_L; }
        else { const int u2 = unit - 512; b = u2 >> 4; e = u2 & 15; chunk = 0; T = CTX; cap = CAP_C; row0 = NLAT + b * CTX; xs_base = 16384 + e * 256 + b * CAP_C; }
        unsigned key[8]; unsigned vmask = 0;
        { float tv[8];
#pragma unroll
          for (int q = 0; q < 8; ++q) { const int i = tid + 512 * q; tv[q] = i < T ? a->AFFT[(size_t)e * NROW + row0 + i] : 0.f; }
#pragma unroll
          for (int q = 0; q < 8; ++q) { const int i = tid + 512 * q; const unsigned u = __builtin_bit_cast(unsigned, tv[q]); key[q] = (u & 0x80000000u) ? ~u : (u | 0x80000000u); if (i < T) vmask |= 1u << q; } }
        hist[tid] = 0; hist[tid + 512] = 0;
        LDS_BAR();
        unsigned prefix = 0; int rem = cap;
#pragma unroll
        for (int p = 0; p < 4; ++p) {
            const int sh = 24 - 8 * p;
#pragma unroll
            for (int q = 0; q < 8; ++q) { const int d = (int)((key[q] >> sh) & 255u);
                if (p == 0) {
                    const bool act = (vmask >> q) & 1u; unsigned long long m = __ballot(act);
                    while (m) { const int l0 = __builtin_ctzll(m); const int d0 = __shfl(d, l0); const unsigned long long same = __ballot(act && d == d0);
                        if (lane == l0) __hip_atomic_fetch_add(hist + d0, (int)__builtin_popcountll(same), __ATOMIC_RELAXED, __HIP_MEMORY_SCOPE_WORKGROUP); m &= ~same; }
                } else { const bool act = ((vmask >> q) & 1u) && ((key[q] >> (sh + 8)) == (prefix >> (sh + 8)));
                    if (act) __hip_atomic_fetch_add(hist + p * 256 + d, 1, __ATOMIC_RELAXED, __HIP_MEMORY_SCOPE_WORKGROUP); } }
            LDS_BAR();
            if (wave == 0) {
                const int h0 = hist[p * 256 + 4 * lane], h1 = hist[p * 256 + 4 * lane + 1], h2 = hist[p * 256 + 4 * lane + 2], h3 = hist[p * 256 + 4 * lane + 3];
                const int tot = h0 + h1 + h2 + h3; int suf = tot;
#pragma unroll
                for (int off = 1; off < 64; off <<= 1) { const int o = __shfl_down(suf, off); if (lane + off < 64) suf += o; }
                const int G3 = suf - tot, G2 = G3 + h3, G1 = G2 + h2, G0 = G1 + h1;
                int found = -1, g = 0;
                if (G3 < rem && rem <= G3 + h3) { found = 3; g = G3; } else if (G2 < rem && rem <= G2 + h2) { found = 2; g = G2; }
                else if (G1 < rem && rem <= G1 + h1) { found = 1; g = G1; } else if (G0 < rem && rem <= G0 + h0) { found = 0; g = G0; }
                if (found >= 0) { ctl[0] = 4 * lane + found; ctl[1] = rem - g; } }
            LDS_BAR();
            prefix |= (unsigned)ctl[0] << sh; rem = ctl[1];
        }
        unsigned gtm = 0, eqm = 0; int we = 0;
#pragma unroll
        for (int q = 0; q < 8; ++q) { const bool v = (vmask >> q) & 1u; if (v && key[q] > prefix) gtm |= 1u << q; const bool eq = v && key[q] == prefix; if (eq) eqm |= 1u << q; we += (int)__builtin_popcountll(__ballot(eq)); }
        if (lane == 0) ctl[24 + wave] = we;
        if (tid == 0) ctl[2] = 0;
        LDS_BAR();
        int E = 0;
#pragma unroll
        for (int w = 0; w < NWAVES; ++w) E += ctl[24 + w];
        unsigned selm = gtm | eqm;
        if (E != rem) {
#pragma unroll
            for (int q = 0; q < 8; ++q) if ((eqm >> q) & 1u) { const int pos = __hip_atomic_fetch_add(ctl + 2, 1, __ATOMIC_RELAXED, __HIP_MEMORY_SCOPE_WORKGROUP); eql[pos] = tid + 512 * q; }
            LDS_BAR();
            selm = gtm;
#pragma unroll 1
            for (int q = 0; q < 8; ++q) if ((eqm >> q) & 1u) { const int i = tid + 512 * q; int c = 0; for (int j = 0; j < E; ++j) c += (eql[j] < i) ? 1 : 0; if (c < rem) selm |= 1u << q; }
        }
        const int c0 = chunk * 256, qs = chunk >> 1; const bool mychunk = (tid >> 8) == (chunk & 1);
        int wb = 0; bool sq = false;
#pragma unroll
        for (int q = 0; q < 8; ++q) { const bool sl = (selm >> q) & 1u; wb += (int)__builtin_popcountll(__ballot(sl && (tid + 512 * q) < c0)); if (q == qs) sq = sl; }
        const unsigned long long cm = __ballot(mychunk && sq);
        if (lane == 0) { ctl[8 + wave] = wb; ctl[16 + wave] = (int)__builtin_popcountll(cm); }
        LDS_BAR();
        int before = 0, woff = 0, n = 0;
#pragma unroll
        for (int w = 0; w < NWAVES; ++w) { before += ctl[8 + w]; const int c = ctl[16 + w]; if (w < wave) woff += c; n += c; }
        if (mychunk) { const int t = c0 + (tid & 255); const int pin = (int)__builtin_popcountll(cm & ((1ull << lane) - 1ull)); const int pos = before + woff + pin;
            a->SEL[(size_t)(row0 + t) * NEXP + e] = sq ? xs_base + pos : -1;
            if (sq) lst[woff + pin] = t | (pos << 16); }
        LDS_BAR();
        for (int idx0 = wave; idx0 < n; idx0 += 4 * NWAVES) { v4u tb[4][4]; int xr[4];
#pragma unroll
            for (int j = 0; j < 4; ++j) { const int idx = idx0 + j * NWAVES; xr[j] = -1;
                if (idx < n) { const int pr = lst[idx], tt = pr & 0xffff; xr[j] = xs_base + (pr >> 16); const v4u* src = (const v4u*)(a->HB + (size_t)(row0 + tt) * DM) + lane;
                    tb[j][0] = src[0]; tb[j][1] = src[64]; tb[j][2] = src[128]; tb[j][3] = src[192]; } }
#pragma unroll
            for (int j = 0; j < 4; ++j) if (xr[j] >= 0) { v4u* dst = (v4u*)(a->XS + (size_t)xr[j] * DM) + lane; dst[0] = tb[j][0]; dst[64] = tb[j][1]; dst[128] = tb[j][2]; dst[192] = tb[j][3]; } }
        LDS_BAR();
    }
}

__device__ __forceinline__ void phase_ln2(KA a, int l, int nrows, int wave, int lane) {
    const int gw = blockIdx.x * NWAVES + wave, NGW = gridDim.x * NWAVES; const bool last = (l == 1);
    const f32x4v* gn = (const f32x4v*)(a->ln_gain + (size_t)(l * 2 + 1) * DM) + 2 * lane; const f32x4v* bs = (const f32x4v*)(a->ln_bias + (size_t)(l * 2 + 1) * DM) + 2 * lane;
    for (int row = gw; row < nrows; row += NGW) {
        const int s = stream_of_row(row);
        f32x4v f[8];
#pragma unroll
        for (int i = 0; i < 8; ++i) f[i] = (f32x4v){0.f, 0.f, 0.f, 0.f};
        const f32x4v* md = (const f32x4v*)(a->MOD + (size_t)(l * 3 + s) * (NMOD * DM)) + 2 * lane;
        f32x4v* xp = (f32x4v*)(a->X + (size_t)row * DM) + 2 * lane;
        int myxr = -1; float myg = 0.f;
        if (lane < NEXP) { myxr = a->SEL[(size_t)row * NEXP + lane]; myg = a->AFF[(size_t)row * NEXP + lane]; }
        f32x4v xv[8], m5[8];
#pragma unroll
        for (int i = 0; i < 8; ++i) { const int o = 128 * (i >> 1) + (i & 1); xv[i] = __builtin_nontemporal_load(xp + o); m5[i] = md[5 * (DM / 4) + o]; }
        unsigned long long mask = __ballot(myxr >= 0);
#define ACC8(W, G, I) do { f[2 * I].x += G * __builtin_bit_cast(float, W.x << 16); f[2 * I].y += G * __builtin_bit_cast(float, W.x & 0xffff0000u); \
            f[2 * I].z += G * __builtin_bit_cast(float, W.y << 16); f[2 * I].w += G * __builtin_bit_cast(float, W.y & 0xffff0000u); \
            f[2 * I + 1].x += G * __builtin_bit_cast(float, W.z << 16); f[2 * I + 1].y += G * __builtin_bit_cast(float, W.z & 0xffff0000u); \
            f[2 * I + 1].z += G * __builtin_bit_cast(float, W.w << 16); f[2 * I + 1].w += G * __builtin_bit_cast(float, W.w & 0xffff0000u); } while (0)
        while (mask) {
            const int e0 = __builtin_ctzll(mask); mask &= mask - 1; const bool two = mask != 0ull; const int e1 = two ? __builtin_ctzll(mask) : e0; if (two) mask &= mask - 1;
            const int xr0 = __shfl(myxr, e0), xr1 = __shfl(myxr, e1); const float g0 = __shfl(myg, e0), g1 = two ? __shfl(myg, e1) : 0.f;
            const v4u* y0 = (const v4u*)(a->YE + (size_t)xr0 * DM) + lane; const v4u* y1 = (const v4u*)(a->YE + (size_t)xr1 * DM) + lane;
            v4u w0[4], w1[4];
#pragma unroll
            for (int i = 0; i < 4; ++i) { w0[i] = __builtin_nontemporal_load(y0 + 64 * i); w1[i] = __builtin_nontemporal_load(y1 + 64 * i); }
#pragma unroll
            for (int i = 0; i < 4; ++i) { ACC8(w0[i], g0, i); ACC8(w1[i], g1, i); }
        }
#undef ACC8
        float sum = 0.f;
#pragma unroll
        for (int i = 0; i < 8; ++i) { f[i] = xv[i] * ALPHA_DN + m5[i] * f[i]; sum += (f[i].x + f[i].y) + (f[i].z + f[i].w); }
        const float mean = wave_sum(sum) * (1.f / DM); float sq = 0.f;
#pragma unroll
        for (int i = 0; i < 8; ++i) { f[i] = f[i] - mean; sq += (f[i].x * f[i].x + f[i].y * f[i].y) + (f[i].z * f[i].z + f[i].w * f[i].w); }
        const float rstd = rsqrtf(wave_sum(sq) * (1.f / DM) + 1e-5f);
        const f32x4v* mdn = (const f32x4v*)(a->MOD + (size_t)((last ? 0 : (l + 1)) * 3 + s) * (NMOD * DM)) + 2 * lane;
        f32x4v* op = (f32x4v*)(a->out + (size_t)row * DM) + 2 * lane; v4u* ho = (v4u*)(a->HB + (size_t)row * DM) + lane;
#pragma unroll
        for (int i = 0; i < 8; ++i) { const int o = 128 * (i >> 1) + (i & 1); xv[i] = gn[o]; }
#pragma unroll
        for (int i = 0; i < 8; ++i) { const int o = 128 * (i >> 1) + (i & 1); m5[i] = bs[o]; }
#pragma unroll
        for (int i = 0; i < 8; ++i) f[i] = f[i] * rstd * xv[i] + m5[i];
        if (last) {
#pragma unroll
            for (int i = 0; i < 8; ++i) { const int o = 128 * (i >> 1) + (i & 1); __builtin_nontemporal_store(f[i], op + o); }
        } else {
            v4u hw[4];
#pragma unroll
            for (int i = 0; i < 8; ++i) { const int o = 128 * (i >> 1) + (i & 1); xv[i] = mdn[1 * (DM / 4) + o]; }
#pragma unroll
            for (int i = 0; i < 8; ++i) { const int o = 128 * (i >> 1) + (i & 1); m5[i] = mdn[o]; }
#pragma unroll
            for (int i = 0; i < 4; ++i) {
                const f32x4v h0 = f[2 * i] * (xv[2 * i] + 1.f) + m5[2 * i], h1 = f[2 * i + 1] * (xv[2 * i + 1] + 1.f) + m5[2 * i + 1];
                hw[i].x = pk2(h0.x, h0.y); hw[i].y = pk2(h0.z, h0.w); hw[i].z = pk2(h1.x, h1.y); hw[i].w = pk2(h1.z, h1.w); }
#pragma unroll
            for (int i = 0; i < 8; ++i) { const int o = 128 * (i >> 1) + (i & 1); __builtin_nontemporal_store(f[i], xp + o); }
#pragma unroll
            for (int i = 0; i < 4; ++i) ho[64 * i] = hw[i];
        }
    }
}

namespace att {
using bf16 = unsigned short;
constexpr int   D = 128, NW = 8, QBLK = 32, KVBLK = 64;
constexpr float SCALE = 0.088388347648318440f;
constexpr float THR = 8.f;
constexpr int SDEPTH = 1;
constexpr int LDQ = 1024, LDK = 256, LDO = 2048;
constexpr size_t SHM_V = KVBLK * D * 2, SHM_K = KVBLK * D * 2, SHM_ATTN = 2 * SHM_V + 2 * SHM_K + NW * 64 * 4;
using bf16x8 = __attribute__((ext_vector_type(8))) short;
using s16x4  = __attribute__((ext_vector_type(4))) short;
using f32x16 = __attribute__((ext_vector_type(16))) float;
using f32x8  = __attribute__((ext_vector_type(8))) float;
using u32x4  = __attribute__((ext_vector_type(4))) unsigned;
#define KSWZ(row, colB) ((row) * 256 + ((colB) ^ (((row) & 7) << 4)))
#define SBAR() __builtin_amdgcn_sched_barrier(0)
__device__ __forceinline__ int crow(int r, int hi) { return (r & 3) + 8 * (r >> 2) + 4 * hi; }
__device__ __forceinline__ unsigned cvtpk(float lo, float hi) {
  unsigned r; asm volatile("v_cvt_pk_bf16_f32 %0, %1, %2" : "=v"(r) : "v"(lo), "v"(hi)); return r;
}
template <typename TIn> struct Stage;
template <> struct Stage<bf16>  { using T = bf16x8;
  __device__ static __forceinline__ T ld8(const bf16* p) { return *reinterpret_cast<const bf16x8*>(p); }
  __device__ static __forceinline__ bf16x8 tobf(T x) { return x; } };
template <> struct Stage<float> { using T = f32x8;
  __device__ static __forceinline__ T ld8(const float* p) { return *reinterpret_cast<const f32x8*>(p); }
  __device__ static __forceinline__ bf16x8 tobf(T x) {
    u32x4 w = {cvtpk(x[0], x[1]), cvtpk(x[2], x[3]), cvtpk(x[4], x[5]), cvtpk(x[6], x[7])}; return *reinterpret_cast<bf16x8*>(&w); } };

__device__ __forceinline__ void partialSM(f32x16& p0, f32x16& p1, float& m_reg, float& mn, float& alpha) {
  constexpr float C = SCALE * 1.4426950408889634f;
  float pmax = p0[0]; for (int r = 1; r < 16; ++r) pmax = fmaxf(pmax, p0[r]); for (int r = 0; r < 16; ++r) pmax = fmaxf(pmax, p1[r]);
  { auto rr = __builtin_amdgcn_permlane32_swap(__float_as_uint(pmax), __float_as_uint(pmax), false, false);
    pmax = fmaxf(__uint_as_float(rr[0]), __uint_as_float(rr[1])); }
  if (__builtin_expect(__all(pmax - m_reg <= THR / SCALE), 1)) { mn = m_reg; alpha = 1.f; }
  else { mn = fmaxf(m_reg, pmax); alpha = __builtin_amdgcn_exp2f((m_reg - mn) * C); m_reg = mn; }
  float mnC = -mn * C;
  for (int r = 0; r < 16; ++r) p0[r] = fmaf(p0[r], C, mnC); for (int r = 0; r < 16; ++r) p1[r] = fmaf(p1[r], C, mnC);
  for (int r = 0; r < 16; ++r) p0[r] = __builtin_amdgcn_exp2f(p0[r]);
}
__device__ __forceinline__ void finishSM(f32x16& p0, f32x16& p1, float alpha, float& l_reg, bf16x8& pa0, bf16x8& pa1, bf16x8& pa2, bf16x8& pa3) {
  for (int r = 0; r < 16; ++r) p1[r] = __builtin_amdgcn_exp2f(p1[r]);
  float ps = 0; for (int r = 0; r < 16; ++r) ps += p0[r]; for (int r = 0; r < 16; ++r) ps += p1[r];
  { auto rr = __builtin_amdgcn_permlane32_swap(__float_as_uint(ps), __float_as_uint(ps), false, false);
    ps = __uint_as_float(rr[0]) + __uint_as_float(rr[1]); }
  l_reg = l_reg * alpha + ps;
#define PK4(P, BASE, OUT) do { unsigned a0 = cvtpk(P[BASE + 0], P[BASE + 1]), a1 = cvtpk(P[BASE + 2], P[BASE + 3]);   \
    unsigned b0 = cvtpk(P[BASE + 4], P[BASE + 5]), b1 = cvtpk(P[BASE + 6], P[BASE + 7]);                              \
    auto r0 = __builtin_amdgcn_permlane32_swap(a0, b0, false, false); auto r1 = __builtin_amdgcn_permlane32_swap(a1, b1, false, false); \
    u32x4 w = {r0[0], r1[0], r0[1], r1[1]}; OUT = *reinterpret_cast<bf16x8*>(&w); } while (0)
  PK4(p0, 0, pa0); PK4(p0, 8, pa1); PK4(p1, 0, pa2); PK4(p1, 8, pa3);
#undef PK4
}
__device__ __forceinline__ void qkt(f32x16& p0, f32x16& p1, const bf16* Ks, const bf16x8* qr, int r32, int hi) {
  p0 = f32x16{}; p1 = f32x16{};
  for (int d0 = 0; d0 < 8; ++d0) { int cb = (d0 * 16 + hi * 8) * 2;
    bf16x8 b0 = *reinterpret_cast<const bf16x8*>((const char*)Ks + KSWZ(r32, cb));
    bf16x8 b1 = *reinterpret_cast<const bf16x8*>((const char*)Ks + KSWZ(32 + r32, cb));
    p0 = __builtin_amdgcn_mfma_f32_32x32x16_bf16(b0, qr[d0], p0, 0, 0, 0);
    p1 = __builtin_amdgcn_mfma_f32_32x32x16_bf16(b1, qr[d0], p1, 0, 0, 0); }
}
__device__ __forceinline__ int v_st(int k, int c) { const int kk = (k & ~0xC) | ((k & 4) << 1) | ((k & 8) >> 1); return ((kk >> 3) * 4 + (c >> 5)) * 512 + ((kk & 7) * 32 + (c & 31)) * 2; }
__device__ __forceinline__ int v_rd_base(int lane) { return ((lane & 3) << 3) | (((lane >> 2) & 3) << 6) | (((lane >> 4) & 1) << 5) | (((lane >> 5) & 1) << 8); }
constexpr int v_rd_off(int d0, int ks, int half) { return d0 * 512 + ks * 4096 + half * 2048; }
template <int OFF> __device__ __forceinline__ s16x4 tr_read(int vb) {
  s16x4 r; asm volatile("ds_read_b64_tr_b16 %0, %1 offset:%2" : "=&v"(r) : "v"(vb), "i"(OFF) : "memory"); return r;
}
template <int D0> __device__ __forceinline__ void pv_one(f32x16& od, int vb, bf16x8 pa0, bf16x8 pa1, bf16x8 pa2, bf16x8 pa3) {
  const s16x4 l0 = tr_read<v_rd_off(D0, 0, 0)>(vb), h0 = tr_read<v_rd_off(D0, 0, 1)>(vb), l1 = tr_read<v_rd_off(D0, 1, 0)>(vb), h1 = tr_read<v_rd_off(D0, 1, 1)>(vb);
  const s16x4 l2 = tr_read<v_rd_off(D0, 2, 0)>(vb), h2 = tr_read<v_rd_off(D0, 2, 1)>(vb), l3 = tr_read<v_rd_off(D0, 3, 0)>(vb), h3 = tr_read<v_rd_off(D0, 3, 1)>(vb);
  asm volatile("s_waitcnt lgkmcnt(0)" ::: "memory"); SBAR();
#define PK(L, H) (bf16x8){L[0], L[1], L[2], L[3], H[0], H[1], H[2], H[3]}
  od = __builtin_amdgcn_mfma_f32_32x32x16_bf16(pa0, PK(l0, h0), od, 0, 0, 0);
  od = __builtin_amdgcn_mfma_f32_32x32x16_bf16(pa1, PK(l1, h1), od, 0, 0, 0);
  od = __builtin_amdgcn_mfma_f32_32x32x16_bf16(pa2, PK(l2, h2), od, 0, 0, 0);
  od = __builtin_amdgcn_mfma_f32_32x32x16_bf16(pa3, PK(l3, h3), od, 0, 0, 0);
#undef PK
}
__device__ __forceinline__ void pv_d0(f32x16* o, int vb, bf16x8 pa0, bf16x8 pa1, bf16x8 pa2, bf16x8 pa3) {
  pv_one<0>(o[0], vb, pa0, pa1, pa2, pa3); pv_one<1>(o[1], vb, pa0, pa1, pa2, pa3); pv_one<2>(o[2], vb, pa0, pa1, pa2, pa3); pv_one<3>(o[3], vb, pa0, pa1, pa2, pa3);
}

template <typename TQ>
__device__ __forceinline__ void attn_dense_body(const TQ* __restrict__ Qb, const bf16* __restrict__ Kh, const bf16* __restrict__ Vh,
                                                unsigned short* __restrict__ Ob, int seq, char* lds) {
  using St = Stage<bf16>; using SQ = Stage<TQ>;
  int tid_ = threadIdx.x; asm volatile("" : "+v"(tid_));
  const int tid = tid_, wid = tid >> 6, lane = tid & 63, r32 = lane & 31, hi = lane >> 5;
  bf16* V_lds = (bf16*)lds; bf16* K_lds = (bf16*)(lds + 2 * SHM_V);
  float* ws = (float*)(lds + 2 * SHM_V + 2 * SHM_K) + wid * 64; float* li_l = ws; float* al_l = ws + 32;
  float m_reg = -1e30f, l_reg = 0; f32x16 o[4] = {}; bf16x8 qr[8];
  const TQ* Qw = Qb + (long)(wid * QBLK + r32) * LDQ + hi * 8;
#pragma unroll
  for (int d0 = 0; d0 < 8; ++d0) qr[d0] = SQ::tobf(SQ::ld8(Qw + d0 * 16));
  const int sr = tid >> 4, sc = (tid & 15) * 8, vst0 = v_st(sr, sc), vst1 = v_st(32 + sr, sc);
  const int vb0 = (int)(uintptr_t)V_lds + v_rd_base(lane);
  struct { typename St::T vs0, vs1, ks0, ks1; } sr_[SDEPTH];
#define SLOAD(i, k0) do { sr_[i].vs0 = St::ld8(&Vh[(long)((k0) + sr) * LDK + sc]); sr_[i].vs1 = St::ld8(&Vh[(long)((k0) + 32 + sr) * LDK + sc]); \
    sr_[i].ks0 = St::ld8(&Kh[(long)((k0) + sr) * LDK + sc]); sr_[i].ks1 = St::ld8(&Kh[(long)((k0) + 32 + sr) * LDK + sc]); } while (0)
#define SWRITE(b, i) do { *(bf16x8*)((char*)V_lds + (b) * SHM_V + vst0) = St::tobf(sr_[i].vs0);          \
    *(bf16x8*)((char*)V_lds + (b) * SHM_V + vst1) = St::tobf(sr_[i].vs1); int kc = sc * 2;               \
    *(bf16x8*)((char*)K_lds + (b) * SHM_K + KSWZ(sr, kc)) = St::tobf(sr_[i].ks0);                       \
    *(bf16x8*)((char*)K_lds + (b) * SHM_K + KSWZ(32 + sr, kc)) = St::tobf(sr_[i].ks1); } while (0)
#define SWAIT() do { if constexpr (SDEPTH == 2) asm volatile("s_waitcnt vmcnt(4)" ::: "memory"); else asm volatile("s_waitcnt vmcnt(0)" ::: "memory"); } while (0)
#define RESC(a) do { if (__any((a) < 1.f)) { if (hi == 0) al_l[r32] = (a); asm volatile("s_waitcnt lgkmcnt(0)" ::: "memory"); \
    for (int d = 0; d < 4; ++d) for (int r = 0; r < 16; ++r) o[d][r] *= al_l[crow(r, hi)]; } } while (0)
  f32x16 pA0, pA1, pB0, pB1; float mnA, mnB, alA, alB; bf16x8 pa0, pa1, pa2, pa3; const int NT = seq / KVBLK;
  constexpr int SE = 0, SO = SDEPTH - 1;
  SLOAD(SE, 0); asm volatile("s_waitcnt vmcnt(0)" ::: "memory"); SWRITE(0, SE); __syncthreads();
  qkt(pA0, pA1, K_lds, qr, r32, hi); partialSM(pA0, pA1, m_reg, mnA, alA);
  SLOAD(SO, KVBLK); if constexpr (SDEPTH == 2) { if (2 < NT) SLOAD(SE, 2 * KVBLK); }
  SWAIT(); SWRITE(1, SO); __syncthreads();
  for (int j = 1; j + 1 < NT; j += 2) {
    SBAR(); qkt(pB0, pB1, (bf16*)((char*)K_lds + SHM_K), qr, r32, hi);
    finishSM(pA0, pA1, alA, l_reg, pa0, pa1, pa2, pa3); SBAR();
    SLOAD(SO, (j + SDEPTH) * KVBLK); SBAR();
    pv_d0(o, vb0, pa0, pa1, pa2, pa3); partialSM(pB0, pB1, m_reg, mnB, alB);
    __syncthreads(); SWAIT(); SWRITE(0, SE);
    RESC(alB); __syncthreads();
    SBAR(); qkt(pA0, pA1, K_lds, qr, r32, hi);
    finishSM(pB0, pB1, alB, l_reg, pa0, pa1, pa2, pa3); SBAR();
    if (SDEPTH == 1 || j + 3 < NT) SLOAD(SE, (j + 1 + SDEPTH) * KVBLK); SBAR();
    pv_d0(o, vb0 + (int)SHM_V, pa0, pa1, pa2, pa3); partialSM(pA0, pA1, m_reg, mnA, alA);
    __syncthreads(); SWAIT(); SWRITE(1, SO);
    RESC(alA); __syncthreads();
  }
  SBAR(); qkt(pB0, pB1, (bf16*)((char*)K_lds + SHM_K), qr, r32, hi);
  finishSM(pA0, pA1, alA, l_reg, pa0, pa1, pa2, pa3); SBAR();
  pv_d0(o, vb0, pa0, pa1, pa2, pa3); partialSM(pB0, pB1, m_reg, mnB, alB);
  __syncthreads(); RESC(alB);
  finishSM(pB0, pB1, alB, l_reg, pa0, pa1, pa2, pa3); SBAR();
  pv_d0(o, vb0 + (int)SHM_V, pa0, pa1, pa2, pa3);
  if (hi == 0) li_l[r32] = l_reg; asm volatile("s_waitcnt lgkmcnt(0)" ::: "memory");
  float rli[16];
#pragma unroll
  for (int r = 0; r < 16; ++r) rli[r] = __builtin_amdgcn_rcpf(li_l[crow(r, hi)]);
  unsigned short* Ow = Ob + (long)(wid * QBLK) * LDO;
#pragma unroll
  for (int r = 0; r < 16; ++r) { int orow = crow(r, hi);
    for (int d0 = 0; d0 < 4; ++d0) Ow[(long)orow * LDO + d0 * 32 + r32] = (unsigned short)f2bf(o[d0][r] * rli[r]); }
#undef SLOAD
#undef SWRITE
#undef SWAIT
#undef RESC
}

}
#define PC_GLA_Q 0
#define PC_GLA_K 256
#define PC_GLA_V 512
#define PC_GLA_G 1024
#define PC_GDN 1536
#define PC_GDN_Z 3072
#define PC_ATT_Q 3584
#define PC_ATT_K 4608
#define PC_ATT_V 4864
#define NKEY (CTX + SEQ)
__device__ __forceinline__ float bflo(unsigned w) { return __builtin_bit_cast(float, w << 16); }
__device__ __forceinline__ float bfhi(unsigned w) { return __builtin_bit_cast(float, w & 0xffff0000u); }
__device__ __forceinline__ float row16_sum(float v) {
#define R16_DPP(CTRL) __builtin_bit_cast(float, __builtin_amdgcn_update_dpp(0, __builtin_bit_cast(int, v), CTRL, 0xF, 0xF, false))
  v += R16_DPP(0xB1); v += R16_DPP(0x4E); v += R16_DPP(0x141); v += R16_DPP(0x140);
#undef R16_DPP
  return v;
}
__device__ __forceinline__ void phase_prep(KA a, int l, LAS unsigned char* lds, int wave, int lane) {
    LAS float* CW = (LAS float*)lds; LAS float* RT = (LAS float*)(lds + 32768);
    { const int tid = wave * 64 + lane;
      for (int i = tid; i < 5 * 1536 / 4; i += NWAVES * 64) ((LAS f32x4v*)CW)[i] = ((const f32x4v*)(a->gdn_conv + (size_t)l * 5 * 1536))[i];
      for (int i = tid; i < 2 * 64 * 16; i += NWAVES * 64) { const int axis = i >> 10, pos = (i >> 4) & 63, c4 = i & 15;
          const float* src = axis == 0 ? a->ROPE + (size_t)(pos * 64) * 128 + (c4 < 8 ? 4 * c4 : 64 + 4 * (c4 - 8)) : a->ROPE + (size_t)pos * 128 + (c4 < 8 ? 32 + 4 * c4 : 96 + 4 * (c4 - 8));
          ((LAS f32x4v*)RT)[i] = *(const f32x4v*)src; }
      LDS_BAR(); }
    const int gw = blockIdx.x * NWAVES + wave, NGW = gridDim.x * NWAVES;
    const int hs = lane >> 4, e0 = 8 * (lane & 15);
    const int axis = (lane & 15) >> 3, ph = (lane >> 2) & 1, f0 = 8 * (lane & 3);
    f32x4v gq0, gq1, gk0, gk1;
    { const float* gp = a->attn_qk_norm + (size_t)l * 256; gq0 = *(const f32x4v*)(gp + e0); gq1 = *(const f32x4v*)(gp + e0 + 4); gk0 = *(const f32x4v*)(gp + 128 + e0); gk1 = *(const f32x4v*)(gp + 128 + e0 + 4); }
    for (int g = gw; g < NROW / 4; g += NGW) {
        const int row0 = 4 * g;
#pragma unroll 1
        for (int rh = 0; rh < 4; rh += 2) { v4u w[2][3];
#pragma unroll
          for (int rr = 0; rr < 2; ++rr)
#pragma unroll
              for (int j = 0; j < 3; ++j) w[rr][j] = *(const v4u*)(a->P + (size_t)(row0 + rh + rr) * PW + PC_ATT_Q + j * 512 + lane * 8);
#pragma unroll
          for (int rr = 0; rr < 2; ++rr) { const int row = row0 + rh + rr; const bool lat = row < NLAT; const int t = row & (SEQ - 1);
              f32x4v c0 = {1.f, 1.f, 1.f, 1.f}, c1 = c0, s0 = {0.f, 0.f, 0.f, 0.f}, s1 = s0;
              if (lat) { const LAS f32x4v* rp = (const LAS f32x4v*)(RT + ((axis * 64 + (axis ? (t & 63) : (t >> 6))) * 64)) + (f0 >> 2); c0 = rp[0]; c1 = rp[1]; s0 = rp[8]; s1 = rp[9]; }
#pragma unroll
              for (int j = 0; j < 3; ++j) { const v4u ww = w[rr][j]; const bool isv = (j == 2) && lane >= 32; v4u ow = ww;
                  if (!isv) { float x[8] = {bflo(ww.x), bfhi(ww.x), bflo(ww.y), bfhi(ww.y), bflo(ww.z), bfhi(ww.z), bflo(ww.w), bfhi(ww.w)};
                      float ss = 0.f;
#pragma unroll
                      for (int q = 0; q < 8; ++q) ss += x[q] * x[q];
                      const float sc = rsqrtf(row16_sum(ss) * (1.f / 128.f) + 1e-6f);
                      const f32x4v g0 = (j == 2) ? gk0 : gq0, g1 = (j == 2) ? gk1 : gq1;
#pragma unroll
                      for (int q = 0; q < 4; ++q) { x[q] = x[q] * sc * g0[q]; x[4 + q] = x[4 + q] * sc * g1[q]; }
                      if (lat) {
#pragma unroll
                          for (int q = 0; q < 8; ++q) { const float pq = __shfl_xor(x[q], 4); const float cq = q < 4 ? c0[q] : c1[q - 4], sq = q < 4 ? s0[q] : s1[q - 4];
                              x[q] = ph == 0 ? x[q] * cq - pq * sq : x[q] * cq + pq * sq; } }
                      ow = (v4u){pk2(x[0], x[1]), pk2(x[2], x[3]), pk2(x[4], x[5]), pk2(x[6], x[7])}; }
                  if (j < 2) *(v4u*)(a->QB + (size_t)row * 1024 + j * 512 + lane * 8) = ow;
                  else { const int b = lat ? row >> 12 : (row - NLAT) >> 8, jk = lat ? CTX + t : (row - NLAT) & (CTX - 1);
                      *(v4u*)((lane < 32 ? a->KB : a->VB) + (size_t)(b * NKEY + jk) * 256 + (lane & 31) * 8) = ow; } } } }
        { int start, len; if (row0 < NLAT) { start = row0 & ~(SEQ - 1); len = SEQ; } else { start = NLAT + ((row0 - NLAT) & ~(CTX - 1)); len = CTX; }
#pragma unroll 1
          for (int j = 0; j < 3; ++j) { v4u w8[8];
#pragma unroll
              for (int i = 0; i < 8; ++i) { const int r = row0 - 2 + i; w8[i] = (r >= start && r < start + len) ? *(const v4u*)(a->P + (size_t)r * PW + PC_GDN + j * 512 + lane * 8) : (v4u){0u, 0u, 0u, 0u}; }
              f32x4v cw[5][2];
#pragma unroll
              for (int tp = 0; tp < 5; ++tp) { const LAS f32x4v* cp = (const LAS f32x4v*)(CW + tp * 1536 + j * 512 + lane * 8); cw[tp][0] = cp[0]; cw[tp][1] = cp[1]; }
#pragma unroll
              for (int rr = 0; rr < 4; ++rr) { float y[8] = {0.f, 0.f, 0.f, 0.f, 0.f, 0.f, 0.f, 0.f};
#pragma unroll
                  for (int tp = 0; tp < 5; ++tp) { const v4u ww = w8[rr + tp];
                      y[0] += bflo(ww.x) * cw[tp][0].x; y[1] += bfhi(ww.x) * cw[tp][0].y; y[2] += bflo(ww.y) * cw[tp][0].z; y[3] += bfhi(ww.y) * cw[tp][0].w;
                      y[4] += bflo(ww.z) * cw[tp][1].x; y[5] += bfhi(ww.z) * cw[tp][1].y; y[6] += bflo(ww.w) * cw[tp][1].z; y[7] += bfhi(ww.w) * cw[tp][1].w; }
                  float ss = 0.f;
#pragma unroll
                  for (int q = 0; q < 8; ++q) { y[q] = silu_f(y[q]); ss += y[q] * y[q]; }
                  if (j < 2) { float sc = rsqrtf(row16_sum(ss) + 1e-6f); if (j == 0) sc *= 0.08838834764831845f;
#pragma unroll
                      for (int q = 0; q < 8; ++q) y[q] *= sc; }
                  *(v4u*)(a->GQKV + (size_t)(row0 + rr) * 1536 + j * 512 + lane * 8) = (v4u){pk2(y[0], y[1]), pk2(y[2], y[3]), pk2(y[4], y[5]), pk2(y[6], y[7])}; } } }
        if (lane < 32) { const int row = row0 + (lane >> 3), idx = lane & 7, z = idx >> 2, h = idx & 3;
            const float pb = a->PG[(size_t)row * 64 + 32 + idx], pa = a->PG[(size_t)row * 64 + 40 + idx];
            a->BETA[((size_t)z * NROW + row) * 4 + h] = sigmoid_f(pb);
            a->GG[((size_t)z * NROW + row) * 4 + h] = -__expf(a->gdn_a_log[l * 8 + idx]) * softplus_f(pa + a->gdn_dt_bias[l * 8 + idx]); }
    }
}
typedef short bf16x8v __attribute__((ext_vector_type(8)));
typedef float f32x16v __attribute__((ext_vector_type(16)));
#define MFMA32(A_, B_, C_) __builtin_amdgcn_mfma_f32_32x32x16_bf16(A_, B_, C_, 0, 0, 0)
__device__ __forceinline__ int crow_(int r, int hi) { return (r & 3) + 8 * (r >> 2) + 4 * hi; }
__device__ __forceinline__ bf16x8v fragL(const LAS unsigned char* base, int pitchB, int row, int k) { return *(const LAS bf16x8v*)(base + row * pitchB + k * 2); }
__device__ __forceinline__ bf16x8v fragG(const bf16_t* base, int ld, int row, int k) { return *(const bf16x8v*)(base + (size_t)row * ld + k); }
__device__ __forceinline__ int chunk_row(int b, int dir, int n, int i) {
    if (n < 4) { const int p = 64 * n + i; return NLAT + b * CTX + (dir ? CTX - 1 - p : p); }
    const int p = 64 * (n - 4) + i; return b * SEQ + (dir ? SEQ - 1 - p : p);
}
#define NCH 68
#define P144 144
#define P272 272
__device__ __forceinline__ void gla_stage_w(KA a, int l, int z, int h, LAS float* WL, int tid) {
    if (tid < 256) { const int j = tid >> 4, c4 = tid & 15; *(LAS f32x4v*)(WL + j * 64 + 4 * c4) = *(const f32x4v*)(a->gla_w_up + ((size_t)(l * 2 + z) * 16 + j) * 256 + h * 64 + 4 * c4); }
    else if (tid < 272) { const int c4 = tid - 256; *(LAS f32x4v*)(WL + 1024 + 4 * c4) = *(const f32x4v*)(a->gla_b_up + (size_t)(l * 2 + z) * 256 + h * 64 + 4 * c4); }
}
__device__ __forceinline__ void gla_loga8(KA a, const LAS float* WL, int z, int row, int k8, float (&la)[8]) {
    const f32x4v* rp = (const f32x4v*)(a->PG + (size_t)row * 64 + z * 16);
    const f32x4v r0 = rp[0], r1 = rp[1], r2 = rp[2], r3 = rp[3]; const float rj[16] = {r0.x, r0.y, r0.z, r0.w, r1.x, r1.y, r1.z, r1.w, r2.x, r2.y, r2.z, r2.w, r3.x, r3.y, r3.z, r3.w};
    const f32x4v b0 = *(const LAS f32x4v*)(WL + 1024 + k8), b1 = *(const LAS f32x4v*)(WL + 1024 + k8 + 4);
    float acc[8] = {b0.x, b0.y, b0.z, b0.w, b1.x, b1.y, b1.z, b1.w};
#pragma unroll
    for (int j = 0; j < 16; ++j) { const f32x4v w0 = *(const LAS f32x4v*)(WL + j * 64 + k8), w1 = *(const LAS f32x4v*)(WL + j * 64 + k8 + 4);
        acc[0] += rj[j] * w0.x; acc[1] += rj[j] * w0.y; acc[2] += rj[j] * w0.z; acc[3] += rj[j] * w0.w; acc[4] += rj[j] * w1.x; acc[5] += rj[j] * w1.y; acc[6] += rj[j] * w1.z; acc[7] += rj[j] * w1.w; }
#pragma unroll
    for (int q = 0; q < 8; ++q) la[q] = logsigmoid_f(acc[q]) * (1.f / 16.f);
}
__device__ __forceinline__ void gla_loga8r(const LAS float* WL, const f32x4v r0, const f32x4v r1, const f32x4v r2, const f32x4v r3, int k8, float (&la)[8]) {
    const float rj[16] = {r0.x, r0.y, r0.z, r0.w, r1.x, r1.y, r1.z, r1.w, r2.x, r2.y, r2.z, r2.w, r3.x, r3.y, r3.z, r3.w};
    const f32x4v b0 = *(const LAS f32x4v*)(WL + 1024 + k8), b1 = *(const LAS f32x4v*)(WL + 1024 + k8 + 4);
    float acc[8] = {b0.x, b0.y, b0.z, b0.w, b1.x, b1.y, b1.z, b1.w};
#pragma unroll
    for (int j = 0; j < 16; ++j) { const f32x4v w0 = *(const LAS f32x4v*)(WL + j * 64 + k8), w1 = *(const LAS f32x4v*)(WL + j * 64 + k8 + 4);
        acc[0] += rj[j] * w0.x; acc[1] += rj[j] * w0.y; acc[2] += rj[j] * w0.z; acc[3] += rj[j] * w0.w; acc[4] += rj[j] * w1.x; acc[5] += rj[j] * w1.y; acc[6] += rj[j] * w1.z; acc[7] += rj[j] * w1.w; }
#pragma unroll
    for (int q = 0; q < 8; ++q) la[q] = logsigmoid_f(acc[q]) * (1.f / 16.f);
}
__device__ __forceinline__ void col_cumsum64(LAS float* M, int tid, int rev) {
    const int k = tid >> 3, seg = tid & 7; float v[8]; float tot = 0.f;
#pragma unroll
    for (int q = 0; q < 8; ++q) { const int i = rev ? 63 - (seg * 8 + q) : seg * 8 + q; tot += M[i * 65 + k]; v[q] = tot; }
    float run = tot;
#pragma unroll
    for (int o = 1; o < 8; o <<= 1) { const float t = __shfl_up(run, o, 8); if (seg >= o) run += t; }
    const float off = run - tot;
#pragma unroll
    for (int q = 0; q < 8; ++q) { const int i = rev ? 63 - (seg * 8 + q) : seg * 8 + q; M[i * 65 + k] = v[q] + off; }
}

__device__ __forceinline__ void gla_kv_unit(KA a, int l, int uid, LAS unsigned char* lds, int tid) {
    const int s = uid / NCH, n = uid % NCH, dir = s & 1, h = (s >> 1) & 3, b = s >> 3;
    LAS float* CUM = (LAS float*)lds;
    LAS unsigned char* KDT = lds + 16640;
    LAS unsigned char* VT = lds + 16640 + 64 * P144;
    LAS float* WL = (LAS float*)(lds + 16640 + 64 * P144 + 128 * P144);
    gla_stage_w(a, l, dir, h, WL, tid); LDS_BAR();
    const int i = tid >> 3, sub = tid & 7, row = chunk_row(b, dir, n, i);
    { float la[8]; gla_loga8(a, WL, dir, row, sub * 8, la);
#pragma unroll
      for (int q = 0; q < 8; ++q) CUM[i * 65 + sub * 8 + q] = la[q]; }
    LDS_BAR();
    col_cumsum64(CUM, tid, 0);
    LDS_BAR();
    { const v4u kw = *(const v4u*)(a->P + (size_t)row * PW + PC_GLA_K + h * 64 + sub * 8); const unsigned kk[4] = {kw.x, kw.y, kw.z, kw.w};
#pragma unroll
      for (int q = 0; q < 8; ++q) { const int k = sub * 8 + q; const float kv = (q & 1) ? bfhi(kk[q >> 1]) : bflo(kk[q >> 1]);
          *(LAS bf16_t*)(KDT + k * P144 + i * 2) = (bf16_t)f2bf(kv * __expf(CUM[63 * 65 + k] - CUM[i * 65 + k])); }
      const v4u v0 = *(const v4u*)(a->P + (size_t)row * PW + PC_GLA_V + h * 128 + sub * 16), v1 = *(const v4u*)(a->P + (size_t)row * PW + PC_GLA_V + h * 128 + sub * 16 + 8);
      const unsigned vv[8] = {v0.x, v0.y, v0.z, v0.w, v1.x, v1.y, v1.z, v1.w};
#pragma unroll
      for (int q = 0; q < 16; ++q) *(LAS bf16_t*)(VT + (sub * 16 + q) * P144 + i * 2) = (bf16_t)((q & 1) ? (vv[q >> 1] >> 16) : (vv[q >> 1] & 0xffffu)); }
    if (tid < 64) a->GDL[(size_t)uid * 64 + tid] = __expf(CUM[63 * 65 + tid]);
    LDS_BAR();
    { const int wave = tid >> 6, lane = tid & 63, r32 = lane & 31, hi = lane >> 5, mt = wave & 1, nt = wave >> 1;
      f32x16v acc = {};
#pragma unroll
      for (int ks = 0; ks < 4; ++ks) acc = MFMA32(fragL(KDT, P144, 32 * mt + r32, 16 * ks + 8 * hi), fragL(VT, P144, 32 * nt + r32, 16 * ks + 8 * hi), acc);
      float* out = a->GKV + (size_t)uid * 8192 + (size_t)(32 * nt + r32) * 64 + 32 * mt + 4 * hi;
#pragma unroll
      for (int g = 0; g < 4; ++g) *(f32x4v*)(out + 8 * g) = (f32x4v){acc[4 * g], acc[4 * g + 1], acc[4 * g + 2], acc[4 * g + 3]}; }
    LDS_BAR();
}
__device__ __forceinline__ void gla_state_scan(KA a, int tid, int wg, int nwg) {
    for (int e = wg * (NWAVES * 64) + tid; e < 16 * 8192; e += nwg * NWAVES * 64) {
        const int s = e >> 13, vk = e & 8191, k = vk & 63; float S = 0.f;
        const float* kv = a->GKV + (size_t)s * NCH * 8192 + vk; const float* dl = a->GDL + (size_t)s * NCH * 64 + k; bf16_t* st = a->GST + (size_t)s * NCH * 8192 + vk;
#pragma unroll 17
        for (int n = 0; n < NCH; ++n) { st[(size_t)n * 8192] = (bf16_t)f2bf(S); S = dl[n * 64] * S + kv[(size_t)n * 8192]; }
    }
}
struct FinPre { unsigned gw[8]; float g0, g1; };
__device__ __forceinline__ void finish_rows_ld(KA a, int row0, const float* gain, int gatecol, int tid, FinPre& f) {
    const int wave = tid >> 6, lane = tid & 63;
    f.g0 = gain[2 * lane]; f.g1 = gain[2 * lane + 1];
#pragma unroll
    for (int rr = 0; rr < 8; ++rr) f.gw[rr] = *(const unsigned*)(a->P + (size_t)(row0 + wave * 8 + rr) * PW + gatecol + 2 * lane);
}
__device__ __forceinline__ void finish_rows_go(KA a, LAS float* OS, int row0, int mixcol, int tid, const FinPre& f) {
    const int wave = tid >> 6, lane = tid & 63;
    float x0[8], x1[8];
#pragma unroll
    for (int rr = 0; rr < 8; ++rr) { const int t = wave * 8 + rr; x0[rr] = OS[t * 130 + 2 * lane]; x1[rr] = OS[t * 130 + 2 * lane + 1]; }
#pragma unroll
    for (int rr = 0; rr < 8; ++rr) { const int t = wave * 8 + rr;
        const float sc = rsqrtf(wave_sum(x0[rr] * x0[rr] + x1[rr] * x1[rr]) * (1.f / 128.f) + 1e-6f);
        *(unsigned*)(a->MIXB + (size_t)(row0 + t) * DM + mixcol + 2 * lane) = pk2(x0[rr] * sc * f.g0 * silu_f(bflo(f.gw[rr])), x1[rr] * sc * f.g1 * silu_f(bfhi(f.gw[rr]))); }
}
__device__ __forceinline__ void gla_out_unit(KA a, int l, int b, int h, int c, int isctx, LAS unsigned char* lds, int tid) {
    const int row0 = isctx ? NLAT + b * CTX + 64 * c : b * SEQ + 64 * c;
    const int nf = isctx ? c : 4 + c, nb = isctx ? 3 - c : 4 + (63 - c);
    const int uf = ((b * 4 + h) * 2 + 0) * NCH + nf, ub = ((b * 4 + h) * 2 + 1) * NCH + nb;
    LAS float* CF = (LAS float*)lds; LAS float* CB = CF + 64 * 65;
    LAS unsigned char* QF = lds + 33280; LAS unsigned char* KF = QF + 64 * P144; LAS unsigned char* QBk = KF + 64 * P144; LAS unsigned char* KBk = QBk + 64 * P144;
    LAS unsigned char* AM = KBk + 64 * P144;
    LAS unsigned char* VT = AM + 64 * P144;
    LAS float* OS = (LAS float*)lds;
    bf16x8v sfb[8];
    { const int wave_ = tid >> 6, lane_ = tid & 63, r32_ = lane_ & 31, hi_ = lane_ >> 5, nt_ = wave_ & 3;
      const bf16_t* Sf_ = a->GST + (size_t)uf * 8192; const bf16_t* Sb_ = a->GST + (size_t)ub * 8192;
#pragma unroll
      for (int ks = 0; ks < 4; ++ks) { sfb[ks] = fragG(Sf_, 64, 32 * nt_ + r32_, 16 * ks + 8 * hi_); sfb[4 + ks] = fragG(Sb_, 64, 32 * nt_ + r32_, 16 * ks + 8 * hi_); } }
    const int t = tid >> 3, sub = tid & 7, row = row0 + t;
    const f32x4v* rp_ = (const f32x4v*)(a->PG + (size_t)row * 64);
    const f32x4v rf0 = rp_[0], rf1 = rp_[1], rf2 = rp_[2], rf3 = rp_[3], rb0 = rp_[4], rb1 = rp_[5], rb2 = rp_[6], rb3 = rp_[7];
    const v4u qw = *(const v4u*)(a->P + (size_t)row * PW + PC_GLA_Q + h * 64 + sub * 8), kw = *(const v4u*)(a->P + (size_t)row * PW + PC_GLA_K + h * 64 + sub * 8);
    const v4u v0 = *(const v4u*)(a->P + (size_t)row * PW + PC_GLA_V + h * 128 + sub * 16), v1 = *(const v4u*)(a->P + (size_t)row * PW + PC_GLA_V + h * 128 + sub * 16 + 8);
    FinPre fp; finish_rows_ld(a, row0, a->gla_norm + l * 128, PC_GLA_G + h * 128, tid, fp);
    LAS float* WL0 = (LAS float*)(lds + 98304); LAS float* WL1 = WL0 + 1088;
    gla_stage_w(a, l, 0, h, WL0, tid); gla_stage_w(a, l, 1, h, WL1, tid); LDS_BAR();
    { float la[8]; gla_loga8r(WL0, rf0, rf1, rf2, rf3, sub * 8, la);
#pragma unroll
      for (int q = 0; q < 8; ++q) CF[t * 65 + sub * 8 + q] = la[q];
      gla_loga8r(WL1, rb0, rb1, rb2, rb3, sub * 8, la);
#pragma unroll
      for (int q = 0; q < 8; ++q) CB[t * 65 + sub * 8 + q] = la[q]; }
    LDS_BAR();
    col_cumsum64(CF, tid, 0); col_cumsum64(CB, tid, 1);
    LDS_BAR();
    { const unsigned qq[4] = {qw.x, qw.y, qw.z, qw.w}, kk[4] = {kw.x, kw.y, kw.z, kw.w};
      unsigned oqf[4], okf[4], oqb[4], okb[4];
#pragma unroll
      for (int p = 0; p < 4; ++p) { const int k0 = sub * 8 + 2 * p; const float q0 = bflo(qq[p]), q1 = bfhi(qq[p]), k0v = bflo(kk[p]), k1v = bfhi(kk[p]);
          const float cf0 = CF[t * 65 + k0], cf1 = CF[t * 65 + k0 + 1], cb0 = CB[t * 65 + k0], cb1 = CB[t * 65 + k0 + 1];
          oqf[p] = pk2(q0 * __expf(cf0), q1 * __expf(cf1)); okf[p] = pk2(k0v * __expf(-cf0), k1v * __expf(-cf1));
          oqb[p] = pk2(q0 * __expf(cb0), q1 * __expf(cb1)); okb[p] = pk2(k0v * __expf(-cb0), k1v * __expf(-cb1)); }
      *(LAS v4u*)(QF + t * P144 + sub * 16) = (v4u){oqf[0], oqf[1], oqf[2], oqf[3]}; *(LAS v4u*)(KF + t * P144 + sub * 16) = (v4u){okf[0], okf[1], okf[2], okf[3]};
      *(LAS v4u*)(QBk + t * P144 + sub * 16) = (v4u){oqb[0], oqb[1], oqb[2], oqb[3]}; *(LAS v4u*)(KBk + t * P144 + sub * 16) = (v4u){okb[0], okb[1], okb[2], okb[3]};
      const unsigned vv[8] = {v0.x, v0.y, v0.z, v0.w, v1.x, v1.y, v1.z, v1.w};
#pragma unroll
      for (int q = 0; q < 16; ++q) *(LAS bf16_t*)(VT + (sub * 16 + q) * P144 + t * 2) = (bf16_t)((q & 1) ? (vv[q >> 1] >> 16) : (vv[q >> 1] & 0xffffu)); }
    LDS_BAR();
    const int wave = tid >> 6, lane = tid & 63, r32 = lane & 31, hi = lane >> 5;
    if (wave < 4) {
        const int mt = wave >> 1, nt = wave & 1; f32x16v af = {}, ab = {};
#pragma unroll
        for (int ks = 0; ks < 4; ++ks) { af = MFMA32(fragL(QF, P144, 32 * mt + r32, 16 * ks + 8 * hi), fragL(KF, P144, 32 * nt + r32, 16 * ks + 8 * hi), af);
                                         ab = MFMA32(fragL(QBk, P144, 32 * mt + r32, 16 * ks + 8 * hi), fragL(KBk, P144, 32 * nt + r32, 16 * ks + 8 * hi), ab); }
        const int sc = 32 * nt + r32;
#pragma unroll
        for (int r = 0; r < 16; ++r) { const int tt = 32 * mt + crow_(r, hi); const float v = (sc <= tt ? af[r] : 0.f) + (sc >= tt ? ab[r] : 0.f);
            *(LAS bf16_t*)(AM + tt * P144 + sc * 2) = (bf16_t)f2bf(v); }
    }
    LDS_BAR();
    { const int mt = wave >> 2, nt = wave & 3; f32x16v o = {};
#pragma unroll
      for (int ks = 0; ks < 4; ++ks) { const int k0 = 16 * ks + 8 * hi;
          o = MFMA32(fragL(AM, P144, 32 * mt + r32, k0), fragL(VT, P144, 32 * nt + r32, k0), o);
          o = MFMA32(fragL(QF, P144, 32 * mt + r32, k0), sfb[ks], o);
          o = MFMA32(fragL(QBk, P144, 32 * mt + r32, k0), sfb[4 + ks], o); }
#pragma unroll
      for (int r = 0; r < 16; ++r) OS[(32 * mt + crow_(r, hi)) * 130 + 32 * nt + r32] = o[r] * 0.125f; }
    LDS_BAR();
    finish_rows_go(a, OS, row0, h * 128, tid, fp);
    LDS_BAR();
}
__device__ __forceinline__ void gdn_chunk_unit(KA a, int uid, LAS unsigned char* lds, int tid) {
    const int s = uid / NCH, n = uid % NCH, dir = s & 1, h = (s >> 1) & 3, b = s >> 3;
    LAS unsigned char* KS = lds; LAS unsigned char* QS = lds + 17408;
    LAS unsigned char* VT = lds + 34816; LAS unsigned char* KBT = lds + 53248; LAS unsigned char* KDT = lds + 71680;
    LAS float* LF = (LAS float*)(lds + 90112); LAS float* TA = (LAS float*)(lds + 106752);
    LAS float* GC = (LAS float*)(lds + 123392); LAS float* BT = GC + 64;
    LAS unsigned char* TS = QS;
    const int wave = tid >> 6, lane = tid & 63, r32 = lane & 31, hi = lane >> 5;
    if (wave == 0) { const int row = chunk_row(b, dir, n, lane);
        float c = a->GG[((size_t)dir * NROW + row) * 4 + h];
#pragma unroll
        for (int o = 1; o < 64; o <<= 1) { const float t = __shfl_up(c, o); if (lane >= o) c += t; }
        GC[lane] = c; BT[lane] = a->BETA[((size_t)dir * NROW + row) * 4 + h]; }
    LDS_BAR();
    const int i = tid >> 3, sub = tid & 7;
    { const int row = chunk_row(b, dir, n, i); const bf16_t* gp = a->GQKV + (size_t)row * 1536 + h * 128 + sub * 16;
      const v4u q0 = *(const v4u*)gp, q1 = *(const v4u*)(gp + 8), k0 = *(const v4u*)(gp + 512), k1 = *(const v4u*)(gp + 520), v0 = *(const v4u*)(gp + 1024), v1 = *(const v4u*)(gp + 1032);
      *(LAS v4u*)(KS + i * P272 + sub * 32) = k0; *(LAS v4u*)(KS + i * P272 + sub * 32 + 16) = k1;
      *(LAS v4u*)(QS + i * P272 + sub * 32) = q0; *(LAS v4u*)(QS + i * P272 + sub * 32 + 16) = q1;
      const float gci = GC[i], bi = BT[i], eg = __expf(gci), ed = __expf(GC[63] - gci);
      const unsigned qq[8] = {q0.x, q0.y, q0.z, q0.w, q1.x, q1.y, q1.z, q1.w}, kk[8] = {k0.x, k0.y, k0.z, k0.w, k1.x, k1.y, k1.z, k1.w}, vv[8] = {v0.x, v0.y, v0.z, v0.w, v1.x, v1.y, v1.z, v1.w};
      unsigned qd[8];
#pragma unroll
      for (int p = 0; p < 8; ++p) { const int d = sub * 16 + 2 * p; const float ka = bflo(kk[p]), kb = bfhi(kk[p]);
          *(LAS bf16_t*)(VT + d * P144 + i * 2) = (bf16_t)f2bf(bi * bflo(vv[p])); *(LAS bf16_t*)(VT + (d + 1) * P144 + i * 2) = (bf16_t)f2bf(bi * bfhi(vv[p]));
          *(LAS bf16_t*)(KBT + d * P144 + i * 2) = (bf16_t)f2bf(bi * eg * ka); *(LAS bf16_t*)(KBT + (d + 1) * P144 + i * 2) = (bf16_t)f2bf(bi * eg * kb);
          *(LAS bf16_t*)(KDT + d * P144 + i * 2) = (bf16_t)f2bf(ed * ka); *(LAS bf16_t*)(KDT + (d + 1) * P144 + i * 2) = (bf16_t)f2bf(ed * kb);
          qd[p] = pk2(eg * bflo(qq[p]), eg * bfhi(qq[p])); }
      const int ir = dir ? 63 - i : i;
      bf16_t* qo = a->QDG + (size_t)uid * 8192 + (size_t)((((ir >> 5) * 8 + sub) * 64 + (ir & 31)) * 8);
      *(v4u*)qo = (v4u){qd[0], qd[1], qd[2], qd[3]}; *(v4u*)(qo + 32 * 8) = (v4u){qd[4], qd[5], qd[6], qd[7]}; }
    LDS_BAR();
    { const int which = wave >> 2, mt = (wave >> 1) & 1, nt = wave & 1; const LAS unsigned char* Am = which ? QS : KS; f32x16v acc = {};
#pragma unroll
      for (int ks = 0; ks < 8; ++ks) acc = MFMA32(fragL(Am, P272, 32 * mt + r32, 16 * ks + 8 * hi), fragL(KS, P272, 32 * nt + r32, 16 * ks + 8 * hi), acc);
      const int j = 32 * nt + r32; const float gcj = GC[j];
#pragma unroll
      for (int r = 0; r < 16; ++r) { const int ii = 32 * mt + crow_(r, hi); const float gam = (ii >= j) ? __expf(GC[ii] - gcj) : 0.f;
          if (which == 0) LF[ii * 65 + j] = (ii > j) ? BT[ii] * acc[r] * gam : 0.f;
          else { const int ir = dir ? 63 - ii : ii; a->AIG[(size_t)uid * 4096 + (size_t)((((ir >> 5) * 4 + (j >> 4)) * 64 + ((j >> 3) & 1) * 32 + (ir & 31)) * 8 + (j & 7))] = (bf16_t)f2bf((ii >= j) ? acc[r] * gam : 0.f); } } }
    LDS_BAR();
    if (wave < 4) { const int I = wave, c = lane & 15; float col[16], lrow[16];
#pragma unroll
        for (int ii = 0; ii < 16; ++ii) lrow[ii] = LF[(16 * I + ii) * 65 + 16 * I + c];
#pragma unroll
        for (int ii = 0; ii < 16; ++ii) { float acc = -lrow[ii];
#pragma unroll
            for (int j = 1; j < ii; ++j) { const float lij = __builtin_bit_cast(float, __builtin_amdgcn_readlane(__builtin_bit_cast(int, lrow[ii]), j)); acc -= (j > c) ? lij * col[j] : 0.f; }
            col[ii] = acc; }
        if (lane < 16) {
#pragma unroll
            for (int ii = 0; ii < 16; ++ii) TA[(16 * I + ii) * 65 + 16 * I + c] = (ii == c) ? 1.f : col[ii]; } }
    { LAS float* XW = (LAS float*)(lds + 123904) + wave * 272; const int r = lane >> 2, c4 = (lane & 3) * 4;
      for (int d = 1; d < 4; ++d) {
        LDS_BAR();
        if (wave < 4 - d) { const int J = wave, I = wave + d; float x[4] = {0.f, 0.f, 0.f, 0.f};
            for (int K = J; K < I; ++K) { float av[16], tv[64];
#pragma unroll
                for (int k = 0; k < 16; ++k) av[k] = LF[(16 * I + r) * 65 + 16 * K + k];
#pragma unroll
                for (int k = 0; k < 16; ++k) {
#pragma unroll
                    for (int q = 0; q < 4; ++q) tv[4 * k + q] = TA[(16 * K + k) * 65 + 16 * J + c4 + q]; }
#pragma unroll
                for (int k = 0; k < 16; ++k) {
#pragma unroll
                    for (int q = 0; q < 4; ++q) x[q] += av[k] * tv[4 * k + q]; } }
#pragma unroll
            for (int q = 0; q < 4; ++q) XW[r * 17 + c4 + q] = x[q];
            float y[4] = {0.f, 0.f, 0.f, 0.f}; float av[16], tv[64];
#pragma unroll
            for (int k = 0; k < 16; ++k) av[k] = TA[(16 * I + r) * 65 + 16 * I + k];
#pragma unroll
            for (int k = 0; k < 16; ++k) {
#pragma unroll
                for (int q = 0; q < 4; ++q) tv[4 * k + q] = XW[k * 17 + c4 + q]; }
#pragma unroll
            for (int k = 0; k < 16; ++k) {
#pragma unroll
                for (int q = 0; q < 4; ++q) y[q] -= av[k] * tv[4 * k + q]; }
#pragma unroll
            for (int q = 0; q < 4; ++q) TA[(16 * I + r) * 65 + 16 * J + c4 + q] = y[q]; }
      } }
    LDS_BAR();
    { float tv[8];
#pragma unroll
      for (int q = 0; q < 8; ++q) { const int j = sub * 8 + q; tv[q] = (j <= i) ? TA[i * 65 + j] : 0.f; }
      *(LAS v4u*)(TS + i * P144 + sub * 16) = (v4u){pk2(tv[0], tv[1]), pk2(tv[2], tv[3]), pk2(tv[4], tv[5]), pk2(tv[6], tv[7])}; }
    LDS_BAR();
    { const int mt = wave >> 2, nt = wave & 3; f32x16v u = {}, w = {};
#pragma unroll
      for (int ks = 0; ks < 4; ++ks) { const bf16x8v tf = fragL(TS, P144, 32 * mt + r32, 16 * ks + 8 * hi);
          u = MFMA32(tf, fragL(VT, P144, 32 * nt + r32, 16 * ks + 8 * hi), u); w = MFMA32(tf, fragL(KBT, P144, 32 * nt + r32, 16 * ks + 8 * hi), w); }
      float* uo = a->UG + (size_t)uid * 8192; bf16_t* wo = a->WG + (size_t)uid * 8192;
#pragma unroll
      for (int r = 0; r < 16; ++r) { const int o = (32 * mt + crow_(r, hi)) * 128 + 32 * nt + r32; uo[o] = u[r]; wo[o] = (bf16_t)f2bf(w[r]); } }
    { const int d = tid >> 2, part = tid & 3; bf16_t* ko = a->KDTG + (size_t)uid * 8192 + d * 64 + part * 16;
      *(v4u*)ko = *(const LAS v4u*)(KDT + d * P144 + part * 32); *(v4u*)(ko + 8) = *(const LAS v4u*)(KDT + d * P144 + part * 32 + 16); }
    if (tid == 0) a->DLASTG[uid] = __expf(GC[63]);
    LDS_BAR();
}
#define ALD16(dst, ptr) asm volatile("global_load_dwordx4 %0, %1, off" : "=v"(dst) : "v"(ptr) : "memory")
#define ALD4(dst, ptr) asm volatile("global_load_dword %0, %1, off" : "=v"(dst) : "v"(ptr) : "memory")
#define ALD16O(dst, ptr, OFF) asm volatile("global_load_dwordx4 %0, %1, off offset:" #OFF : "=v"(dst) : "v"(ptr) : "memory")
#define ALD4O(dst, ptr, OFF) asm volatile("global_load_dword %0, %1, off offset:" #OFF : "=v"(dst) : "v"(ptr) : "memory")
__device__ __forceinline__ void gdn_scan_unit(KA a, int s, int sl, LAS unsigned char* lds, int tid) {
    LAS unsigned char* SB = lds; LAS unsigned char* VN = lds + 32 * P272;
    const int wave = __builtin_amdgcn_readfirstlane(tid >> 6);
    const size_t u0 = (size_t)s * NCH;
#define ROLE_LANE() int lane = tid & 63; asm volatile("" : "+v"(lane)); const int r32 = lane & 31, hi = lane >> 5; (void)r32; (void)hi
    if (wave < 4) {
        ROLE_LANE();
        f32x16v S = {}; bf16x8v kdA[4], kdB[4], kdC[4]; float dlA, dlB, dlC;
#define LD_S(kd, dl, n_) do { const size_t uid_ = u0 + ((n_) < NCH ? (n_) : NCH - 1); const bf16_t* p_ = a->KDTG + uid_ * 8192 + (size_t)(32 * wave + r32) * 64 + 8 * hi; \
            ALD16O(kd[0], p_, 0); ALD16O(kd[1], p_, 32); ALD16O(kd[2], p_, 64); ALD16O(kd[3], p_, 96); const float* q_ = a->DLASTG + uid_; ALD4(dl, q_); } while (0)
#define WAIT_S(kd, dl, N) asm volatile("s_waitcnt vmcnt(" #N ")" : "+v"(kd[0]), "+v"(kd[1]), "+v"(kd[2]), "+v"(kd[3]), "+v"(dl) :: "memory")
#define ST_S() do { _Pragma("unroll") for (int g = 0; g < 4; ++g) { \
            const unsigned long long pk = (unsigned long long)pg8::cvt_pk_bf16(S[4 * g], S[4 * g + 1]) | ((unsigned long long)pg8::cvt_pk_bf16(S[4 * g + 2], S[4 * g + 3]) << 32); const int d0 = 32 * wave + 8 * g + 4 * hi; \
            *(LAS unsigned long long*)(SB + r32 * P272 + d0 * 2) = pk; } } while (0)
#define UP_S(kd, dl) do { bf16x8v bf_[4]; _Pragma("unroll") for (int ks = 0; ks < 4; ++ks) bf_[ks] = fragL(VN, P144, r32, 16 * ks + 8 * hi); S = S * dl; \
            _Pragma("unroll") for (int ks = 0; ks < 4; ++ks) S = MFMA32(kd[ks], bf_[ks], S); } while (0)
        LD_S(kdA, dlA, 0); LD_S(kdB, dlB, 1);
        for (int n = 0; n < NCH - 2; n += 3) {
            LD_S(kdC, dlC, n + 2); ST_S(); LDS_BAR(); LDS_BAR(); WAIT_S(kdA, dlA, 10); UP_S(kdA, dlA);
            LD_S(kdA, dlA, n + 3); ST_S(); LDS_BAR(); LDS_BAR(); WAIT_S(kdB, dlB, 10); UP_S(kdB, dlB);
            LD_S(kdB, dlB, n + 4); ST_S(); LDS_BAR(); LDS_BAR(); WAIT_S(kdC, dlC, 10); UP_S(kdC, dlC);
        }
        ST_S(); LDS_BAR(); LDS_BAR(); WAIT_S(kdA, dlA, 5); UP_S(kdA, dlA);
        ST_S(); LDS_BAR(); LDS_BAR(); WAIT_S(kdB, dlB, 0); UP_S(kdB, dlB);
#undef LD_S
#undef WAIT_S
#undef ST_S
#undef UP_S
    } else if (wave < 6) {
        ROLE_LANE();
        const int mt = wave - 4; bf16x8v wfA[8], wfB[8], wfC[8]; float uuA[16], uuB[16], uuC[16];
#define LD_V(wf, uu, n_) do { const size_t uid_ = u0 + ((n_) < NCH ? (n_) : NCH - 1); const bf16_t* p_ = a->WG + uid_ * 8192 + (size_t)(32 * mt + r32) * 128 + 8 * hi; \
            ALD16O(wf[0], p_, 0); ALD16O(wf[1], p_, 32); ALD16O(wf[2], p_, 64); ALD16O(wf[3], p_, 96); ALD16O(wf[4], p_, 128); ALD16O(wf[5], p_, 160); ALD16O(wf[6], p_, 192); ALD16O(wf[7], p_, 224); \
            const float* q_ = a->UG + uid_ * 8192 + (size_t)(32 * mt + 4 * hi) * 128 + 32 * sl + r32;     \
            ALD4O(uu[0], q_, 0); ALD4O(uu[1], q_, 512); ALD4O(uu[2], q_, 1024); ALD4O(uu[3], q_, 1536); const float* q1_ = q_ + 1024; \
            ALD4O(uu[4], q1_, 0); ALD4O(uu[5], q1_, 512); ALD4O(uu[6], q1_, 1024); ALD4O(uu[7], q1_, 1536); const float* q2_ = q_ + 2048; \
            ALD4O(uu[8], q2_, 0); ALD4O(uu[9], q2_, 512); ALD4O(uu[10], q2_, 1024); ALD4O(uu[11], q2_, 1536); const float* q3_ = q_ + 3072; \
            ALD4O(uu[12], q3_, 0); ALD4O(uu[13], q3_, 512); ALD4O(uu[14], q3_, 1024); ALD4O(uu[15], q3_, 1536); } while (0)
#define WAIT_V(wf, uu, N) asm volatile("s_waitcnt vmcnt(" #N ")" : "+v"(wf[0]), "+v"(wf[1]), "+v"(wf[2]), "+v"(wf[3]), "+v"(wf[4]), "+v"(wf[5]), "+v"(wf[6]), "+v"(wf[7]), \
            "+v"(uu[0]), "+v"(uu[1]), "+v"(uu[2]), "+v"(uu[3]), "+v"(uu[4]), "+v"(uu[5]), "+v"(uu[6]), "+v"(uu[7]), "+v"(uu[8]), "+v"(uu[9]), "+v"(uu[10]), "+v"(uu[11]), "+v"(uu[12]), "+v"(uu[13]), "+v"(uu[14]), "+v"(uu[15]) :: "memory")
#define VN_STEP(wf, uu) do { f32x16v t = {}; bf16x8v bf_[4]; _Pragma("unroll") for (int ks = 0; ks < 4; ++ks) bf_[ks] = fragL(SB, P272, r32, 16 * ks + 8 * hi); \
            _Pragma("unroll") for (int ks = 0; ks < 4; ++ks) t = MFMA32(wf[ks], bf_[ks], t); \
            _Pragma("unroll") for (int ks = 0; ks < 4; ++ks) bf_[ks] = fragL(SB, P272, r32, 16 * (ks + 4) + 8 * hi); \
            _Pragma("unroll") for (int ks = 0; ks < 4; ++ks) t = MFMA32(wf[ks + 4], bf_[ks], t); \
            _Pragma("unroll") for (int g = 0; g < 4; ++g) { \
                const unsigned long long pk = (unsigned long long)pg8::cvt_pk_bf16(uu[4 * g] - t[4 * g], uu[4 * g + 1] - t[4 * g + 1]) | ((unsigned long long)pg8::cvt_pk_bf16(uu[4 * g + 2] - t[4 * g + 2], uu[4 * g + 3] - t[4 * g + 3]) << 32); \
                const int i0 = 32 * mt + 8 * g + 4 * hi; \
                *(LAS unsigned long long*)(VN + r32 * P144 + i0 * 2) = pk; } } while (0)
        LD_V(wfA, uuA, 0); LD_V(wfB, uuB, 1);
        for (int n = 0; n < NCH - 2; n += 3) {
            LD_V(wfC, uuC, n + 2); LDS_BAR(); WAIT_V(wfA, uuA, 48); VN_STEP(wfA, uuA); LDS_BAR();
            LD_V(wfA, uuA, n + 3); LDS_BAR(); WAIT_V(wfB, uuB, 48); VN_STEP(wfB, uuB); LDS_BAR();
            LD_V(wfB, uuB, n + 4); LDS_BAR(); WAIT_V(wfC, uuC, 48); VN_STEP(wfC, uuC); LDS_BAR();
        }
        LDS_BAR(); WAIT_V(wfA, uuA, 24); VN_STEP(wfA, uuA); LDS_BAR();
        LDS_BAR(); WAIT_V(wfB, uuB, 0); VN_STEP(wfB, uuB); LDS_BAR();
#undef LD_V
#undef WAIT_V
#undef VN_STEP
    } else if (wave == 6) {
        ROLE_LANE();
        v4u tA[8], tB[8], tC[8], tD[8];
#define PUB_S(t, n_) do { LDS_BAR(); \
            _Pragma("unroll") for (int it = 0; it < 8; ++it) t[it] = *(const LAS v4u*)(SB + r32 * P272 + (2 * it + hi) * 16); \
            LDS_BAR(); bf16_t* dst = a->SPREV + (u0 + (n_)) * 16384 + (size_t)(sl * 8 * 64 + r32 + 32 * hi) * 8; \
            _Pragma("unroll") for (int it = 0; it < 8; ++it) *(v4u*)(dst + it * 512) = t[it]; } while (0)
        for (int n = 0; n < NCH; n += 4) { PUB_S(tA, n); PUB_S(tB, n + 1); PUB_S(tC, n + 2); PUB_S(tD, n + 3); }
#undef PUB_S
    } else {
        ROLE_LANE(); v4u tA[4], tB[4], tC[4], tD[4];
#define PUB_V(t, n_) do { LDS_BAR(); LDS_BAR(); \
            _Pragma("unroll") for (int it = 0; it < 4; ++it) t[it] = *(const LAS v4u*)(VN + r32 * P144 + (2 * it + hi) * 16); \
            bf16_t* dst = a->VNEW + (u0 + (n_)) * 8192 + (size_t)(sl * 4 * 64 + r32 + 32 * hi) * 8; \
            _Pragma("unroll") for (int it = 0; it < 4; ++it) *(v4u*)(dst + it * 512) = t[it]; } while (0)
        for (int n = 0; n < NCH; n += 4) { PUB_V(tA, n); PUB_V(tB, n + 1); PUB_V(tC, n + 2); PUB_V(tD, n + 3); }
#undef PUB_V
    }
#undef ROLE_LANE
    __syncthreads();
}
__device__ __forceinline__ void gdn_out_unit(KA a, int l, int b, int h, int c, int isctx, LAS unsigned char* lds, int tid) {
    const int row0 = isctx ? NLAT + b * CTX + 64 * c : b * SEQ + 64 * c;
    const int nf = isctx ? c : 4 + c, nb = isctx ? 3 - c : 4 + (63 - c);
    LAS float* OS = (LAS float*)lds;
    const int wave = tid >> 6, lane = tid & 63, r32 = lane & 31, hi = lane >> 5, mt = wave >> 2, nt = wave & 3;
    f32x16v o = {};
    bf16x8v fa[24], fb[24]; FinPre fp;
#pragma unroll
    for (int dsel = 0; dsel < 2; ++dsel) { const size_t uid = (size_t)((b * 4 + h) * 2 + dsel) * NCH + (dsel ? nb : nf);
        const bf16_t* QDp = a->QDG + uid * 8192; const bf16_t* AIp = a->AIG + uid * 4096; const bf16_t* SP = a->SPREV + uid * 16384; const bf16_t* VNp = a->VNEW + uid * 8192;
#pragma unroll
        for (int ks = 0; ks < 8; ++ks) { fa[12 * dsel + ks] = *(const bf16x8v*)(QDp + ((mt * 8 + ks) * 64 + lane) * 8); fb[12 * dsel + ks] = *(const bf16x8v*)(SP + ((nt * 8 + ks) * 64 + lane) * 8); }
#pragma unroll
        for (int ks = 0; ks < 4; ++ks) { fa[12 * dsel + 8 + ks] = *(const bf16x8v*)(AIp + ((mt * 4 + ks) * 64 + lane) * 8); fb[12 * dsel + 8 + ks] = *(const bf16x8v*)(VNp + ((nt * 4 + ks) * 64 + lane) * 8); } }
    finish_rows_ld(a, row0, a->gdn_norm + l * 128, PC_GDN_Z + h * 128, tid, fp);
#pragma unroll
    for (int ks = 0; ks < 24; ++ks) o = MFMA32(fa[ks], fb[ks], o);
#pragma unroll
    for (int r = 0; r < 16; ++r) OS[(32 * mt + crow_(r, hi)) * 130 + 32 * nt + r32] = o[r];
    LDS_BAR();
    finish_rows_go(a, OS, row0, 512 + h * 128, tid, fp);
    LDS_BAR();
}
__device__ __forceinline__ void phase_attn(KA a, int layer0, char* ldsg, int first_unit_shift) {
    const int nunits = layer0 ? 272 : 256; bool firstu = true;
    const int G_ = gridDim.x, cshift = (G_ == 256) ? (int)((blockIdx.x + 192u) & 255u) : (int)blockIdx.x;
    for (int uu = cshift; uu < nunits; uu += G_) {
        const int u = uu;
        if (!firstu) __syncthreads();
        firstu = false;
        const bf16_t *Qp, *Kp, *Vp; bf16_t* Op; int seq;
        if (u < 256) { const int b = u >> 7, hq = (u >> 4) & 7, qb = u & 15, kvh = hq >> 2; seq = NKEY;
            Qp = a->QB + (size_t)(b * SEQ + qb * 256) * 1024 + hq * 128; Kp = a->KB + ((size_t)(b * NKEY) * 2 + kvh) * 128; Vp = a->VB + ((size_t)(b * NKEY) * 2 + kvh) * 128;
            Op = a->MIXB + (size_t)(b * SEQ + qb * 256) * DM + 1024 + hq * 128; }
        else { const int u2 = u - 256, b = u2 >> 3, hq = u2 & 7, kvh = hq >> 2; seq = CTX;
            Qp = a->QB + (size_t)(NLAT + b * CTX) * 1024 + hq * 128; Kp = a->KB + ((size_t)(b * NKEY) * 2 + kvh) * 128; Vp = a->VB + ((size_t)(b * NKEY) * 2 + kvh) * 128;
            Op = a->MIXB + (size_t)(NLAT + b * CTX) * DM + 1024 + hq * 128; }
        att::attn_dense_body<att::bf16>(Qp, Kp, Vp, Op, seq, ldsg);
    }
}
__global__ void __launch_bounds__(NWAVES * 64, 2) __attribute__((amdgpu_waves_per_eu(2, 2))) mega(Args karg) {
    extern __shared__ __attribute__((aligned(16))) unsigned char lds_raw[];
    LAS unsigned char* lds = (LAS unsigned char*)lds_raw;
    const int tid = threadIdx.x, lane = tid & 63, wave = __builtin_amdgcn_readfirstlane(tid >> 6);
    for (int u = tid; u < (LDS_BYTES - LDSCTL_OFF) / 4; u += NWAVES * 64) ((LAS unsigned*)(lds + LDSCTL_OFF))[u] = 0u;
    __syncthreads();
    KA a0 = (KA)__builtin_amdgcn_kernarg_segment_ptr();
#define KARGS() KA a = a0; asm volatile("" : "+s"(a))
    const int lo = a0->ph_lo, hi = a0->ph_hi;
    unsigned* const barw = a0->ctl + CW_BAR + a0->li * XCD_BAR_WORDS; XcdBarrier bar; bar.bar = barw; bar.x = 0; bar.st = nullptr;
    if (hi - lo > 1) bar = xcd_barrier_post(barw, (volatile LAS unsigned*)(lds + MISC_OFF + 32));
#define IN(k) (lo <= (k) && (k) < hi)
#define SEAM(k) do { if (IN(k) && IN((k) + 1)) xcd_barrier(bar); } while (0)

    if (IN(PH_CONV)) { KARGS(); int ln = lane; asm volatile("" : "+v"(ln)); phase_convert(a, lds, wave, ln); } SEAM(PH_CONV);
    if (IN(PH_INIT)) { KARGS(); int ln = lane; asm volatile("" : "+v"(ln)); phase_init(a, wave, ln); } SEAM(PH_INIT);
#define OPQ(p) asm volatile("" : "+s"(p))
#pragma unroll 1
    for (int l = 0; l < 2; ++l) {
        const int pb = NPH_PRO + l * NPH_LAYER; const int layer0 = (l == 0);
        if (IN(pb + L_INPROJ)) { KARGS();
            const bf16_t* Ap = a->HB; const bf16_t* Bp = a->WinT + l * WINT_L; bf16_t* O1 = a->P; float* O2 = a->PG; OPQ(Ap); OPQ(Bp); OPQ(O1); OPQ(O2);
            pg8::Gemm g{Ap, Bp, NROW, NINP, DM}; pg8::StaticOrder S; S.init(NROW, NINP, gridDim.x, blockIdx.x);
            pg8::EpiInProj E{O1, O2};
            pg8::gemm_phase<pg8::EpiInProj, pg8::StaticOrder>(lds, g, S, E, nullptr);
        } SEAM(pb + L_INPROJ);
        if (IN(pb + L_PREP)) { KARGS(); int ln = lane; asm volatile("" : "+v"(ln)); phase_prep(a, l, lds, wave, ln); } SEAM(pb + L_PREP);
        if (IN(pb + L_CHUNK)) { KARGS(); int td = tid; asm volatile("" : "+v"(td));
            for (int uid = blockIdx.x; uid < 16 * NCH; uid += gridDim.x) gdn_chunk_unit(a, uid, lds, td);
            if (gridDim.x == 256) {
                const int g0 = blockIdx.x < 64 ? (int)blockIdx.x * 2 : 128 + ((int)blockIdx.x - 64) * 5, gn = blockIdx.x < 64 ? 2 : 5;
                for (int q = 0; q < gn; ++q) gla_kv_unit(a, l, g0 + q, lds, td);
            } else for (int uid = gridDim.x - 1 - blockIdx.x; uid < 16 * NCH; uid += gridDim.x) gla_kv_unit(a, l, uid, lds, td);
        } SEAM(pb + L_CHUNK);
        if (IN(pb + L_SCAN)) { KARGS(); { int td = tid; asm volatile("" : "+v"(td));
                { const bool side = gridDim.x == 256;
                  if (!side || blockIdx.x >= 64) gla_state_scan(a, td, side ? (int)blockIdx.x - 64 : (int)blockIdx.x, side ? 192 : (int)gridDim.x);
                  for (int su = blockIdx.x; su < 64; su += gridDim.x) gdn_scan_unit(a, su >> 2, su & 3, lds, td); }
                }
            phase_attn(a, layer0, (char*)lds_raw, 0);
            if (gridDim.x == 256 && blockIdx.x >= 64) { __syncthreads(); int ln = lane; asm volatile("" : "+v"(ln)); int wv = wave; asm volatile("" : "+s"(wv));
                conv_range(a, lds, wv, ln, layer0 ? CONV_N0 : CONV_NC, layer0 ? CONV_NA : CONV_NALL, blockIdx.x - 64, 192); } } SEAM(pb + L_SCAN);
        if (IN(pb + L_OUT)) { KARGS(); int td = tid; asm volatile("" : "+v"(td));
            const int nu = layer0 ? 544 : 512;
            for (int u = blockIdx.x; u < nu; u += gridDim.x) { if (u < 512) gdn_out_unit(a, l, u >> 8, (u >> 6) & 3, u & 63, 0, lds, td); else gdn_out_unit(a, l, (u - 512) >> 4, ((u - 512) >> 2) & 3, (u - 512) & 3, 1, lds, td); }
            for (int u = gridDim.x - 1 - blockIdx.x; u < nu; u += gridDim.x) { if (u < 512) gla_out_unit(a, l, u >> 8, (u >> 6) & 3, u & 63, 0, lds, td); else gla_out_unit(a, l, (u - 512) >> 4, ((u - 512) >> 2) & 3, (u - 512) & 3, 1, lds, td); }
        } SEAM(pb + L_OUT);
        if (IN(pb + L_OPROJ)) { KARGS();
            const int nrows = layer0 ? NROW : NLAT;
            const bf16_t* Ap = a->MIXB; const bf16_t* Bp = a->WoutT + l * WOUTT_L; float* O1 = a->Y; OPQ(Ap); OPQ(Bp); OPQ(O1);
            pg8::Gemm g{Ap, Bp, nrows, DM, DM}; pg8::StaticOrder S; S.init(nrows, DM, gridDim.x, blockIdx.x);
            pg8::EpiF32 E{O1, DM, nullptr};
            pg8::gemm_phase<pg8::EpiF32, pg8::StaticOrder>(lds, g, S, E, nullptr);
            if (gridDim.x == 256 && layer0 && blockIdx.x >= 16) { int ln = lane; asm volatile("" : "+v"(ln)); int wv = wave; asm volatile("" : "+s"(wv)); conv_range(a, lds, wv, ln, CONV_NA, CONV_NB, blockIdx.x - 16, 240); }
        } SEAM(pb + L_OPROJ);
        if (IN(pb + L_LN1)) { KARGS(); int ln = lane; asm volatile("" : "+v"(ln)); phase_ln1(a, l, layer0 ? NROW : NLAT, lds, wave, ln); } SEAM(pb + L_LN1);
        if (IN(pb + L_TOPK)) { KARGS(); int td = tid; asm volatile("" : "+v"(td)); phase_topk(a, layer0, lds, td); } SEAM(pb + L_TOPK);
        if (IN(pb + L_FFN1)) { KARGS();
            const bf16_t* Ap = a->XS; const bf16_t* Bp = a->W13T + l * W13T_L; bf16_t* O1 = a->HM; OPQ(Ap); OPQ(Bp); OPQ(O1);
            pg8::Gemm g{Ap, Bp, XSROWS, NEXP * 4096, DM}; pg8::OrderFfn1 S{(int)gridDim.x, (int)blockIdx.x, layer0};
            pg8::EpiSwiGLU E{O1};
            pg8::gemm_phase<pg8::EpiSwiGLU, pg8::OrderFfn1>(lds, g, S, E, nullptr);
        } SEAM(pb + L_FFN1);
        if (IN(pb + L_FFN2)) { KARGS();
            const bf16_t* Ap = a->HM; const bf16_t* Bp = a->W2T + l * W2T_L; bf16_t* O1 = a->YE; OPQ(Ap); OPQ(Bp); OPQ(O1);
            pg8::Gemm g{Ap, Bp, XSROWS, NEXP * DM, EFF}; pg8::OrderFfn2 S{(int)gridDim.x, (int)blockIdx.x, layer0};
            pg8::EpiFfn2 E{O1};
            pg8::gemm_phase<pg8::EpiFfn2, pg8::OrderFfn2>(lds, g, S, E, nullptr);
            if (gridDim.x == 256 && layer0 && blockIdx.x >= 128) { int ln = lane; asm volatile("" : "+v"(ln)); int wv = wave; asm volatile("" : "+s"(wv)); conv_range(a, lds, wv, ln, CONV_NB, CONV_NC, blockIdx.x - 128, 128); }
        } SEAM(pb + L_FFN2);
        if (IN(pb + L_LN2)) { KARGS(); int ln = lane; asm volatile("" : "+v"(ln)); phase_ln2(a, l, layer0 ? NROW : NLAT, wave, ln); }
        if (l == 0) SEAM(pb + L_LN2);
    }
#undef IN
#undef SEAM
}
extern "C" void kernel_launch(void* const* d_in, const int* in_sizes, int n_in, void* d_out, int out_size, void* d_ws, size_t ws_size, hipStream_t stream) {
  static int grid = 0;
  if (grid == 0) {
    int dev = 0, cus = 0;
    if (hipGetDevice(&dev) != hipSuccess || hipDeviceGetAttribute(&cus, hipDeviceAttributeMultiprocessorCount, dev) != hipSuccess) { fprintf(stderr, "device query failed\n"); grid = -1; return; }
    if (hipFuncSetAttribute((const void*)mega, hipFuncAttributeMaxDynamicSharedMemorySize, LDS_BYTES) != hipSuccess) { fprintf(stderr, "hipFuncSetAttribute(mega) failed\n"); grid = -1; return; }
    grid = cus;
  }
  if (grid < 0) return;
  Args a{};
  a.x = (const float*)d_in[0]; a.c = (const float*)d_in[1]; a.ctx = (const float*)d_in[2]; a.c_ctx = (const float*)d_in[3];
  a.w_ada = (const float*)d_in[4]; a.b_ada = (const float*)d_in[5]; a.w_in = (const float*)d_in[6]; a.w_out = (const float*)d_in[7];
  a.gla_w_up = (const float*)d_in[8]; a.gla_b_up = (const float*)d_in[9]; a.gla_norm = (const float*)d_in[10];
  a.gdn_conv = (const float*)d_in[11]; a.gdn_a_log = (const float*)d_in[12]; a.gdn_dt_bias = (const float*)d_in[13]; a.gdn_norm = (const float*)d_in[14];
  a.attn_qk_norm = (const float*)d_in[15]; a.ln_gain = (const float*)d_in[16]; a.ln_bias = (const float*)d_in[17];
  a.router = (const float*)d_in[18]; a.w1 = (const float*)d_in[19]; a.w3 = (const float*)d_in[20]; a.w2 = (const float*)d_in[21];
  a.out = (float*)d_out;
  unsigned char* wsb = (unsigned char*)d_ws; size_t off = 0;
  auto take = [&](size_t bytes) { unsigned char* p = wsb + off; off += (bytes + 255) / 256 * 256; return p; };
  a.ctl = (unsigned*)take(CTL_ZERO_BYTES);
  a.MOD = (float*)take((size_t)2 * 3 * NMOD * DM * 4);
  a.WinT = (bf16_t*)take(2 * WINT_L * 2); a.WoutT = (bf16_t*)take(2 * WOUTT_L * 2); a.W13T = (bf16_t*)take(2 * W13T_L * 2); a.W2T = (bf16_t*)take(2 * W2T_L * 2);
  a.X = (float*)take((size_t)NROW * DM * 4); a.HB = (bf16_t*)take((size_t)NROW * DM * 2); a.P = (bf16_t*)take((size_t)NROW * PW * 2); a.PG = (float*)take((size_t)NROW * 64 * 4);
  a.Y = (float*)take((size_t)NROW * DM * 4); a.MIXB = (bf16_t*)take((size_t)NROW * DM * 2);
  a.XS = (bf16_t*)take((size_t)XSROWS * DM * 2); a.HM = (bf16_t*)take((size_t)XSROWS * DM * 2); a.YE = (bf16_t*)take((size_t)XSROWS * DM * 2);
  a.ROPE = (float*)take((size_t)SEQ * 128 * 4); a.AFF = (float*)take((size_t)NROW * NEXP * 4); a.AFFT = (float*)take((size_t)NROW * NEXP * 4); a.SEL = (int*)take((size_t)NROW * NEXP * 4);
  a.QB = (bf16_t*)take((size_t)NROW * 1024 * 2); a.KB = (bf16_t*)take((size_t)NB * NKEY * 256 * 2); a.VB = (bf16_t*)take((size_t)NB * NKEY * 256 * 2);
  a.GQKV = (bf16_t*)take((size_t)NROW * 1536 * 2); a.BETA = (float*)take((size_t)2 * NROW * 4 * 4); a.GG = (float*)take((size_t)2 * NROW * 4 * 4);
  a.GKV = (float*)take((size_t)16 * NCH * 8192 * 4); a.GDL = (float*)take((size_t)16 * NCH * 64 * 4); a.GST = (bf16_t*)take((size_t)16 * NCH * 8192 * 2);
  a.WG = (bf16_t*)take((size_t)16 * NCH * 8192 * 2); a.KDTG = (bf16_t*)take((size_t)16 * NCH * 8192 * 2); a.QDG = (bf16_t*)take((size_t)16 * NCH * 8192 * 2); a.AIG = (bf16_t*)take((size_t)16 * NCH * 4096 * 2);
  a.SPREV = (bf16_t*)take((size_t)16 * NCH * 16384 * 2); a.VNEW = (bf16_t*)take((size_t)16 * NCH * 8192 * 2); a.UG = (float*)take((size_t)16 * NCH * 8192 * 4); a.DLASTG = (float*)take((size_t)16 * NCH * 4);
  if (off > ws_size) { fprintf(stderr, "ws too small: need %zu have %zu\n", off, ws_size); return; }
  if (hipMemsetAsync(a.ctl, 0, CTL_ZERO_BYTES, stream) != hipSuccess) { fprintf(stderr, "memset failed\n"); return; }
  int li = 0;
  auto run = [&](int lo, int hi) { a.ph_lo = lo; a.ph_hi = hi; a.li = li++; a.pad = 0; hipLaunchKernelGGL(mega, dim3(grid), dim3(NWAVES * 64), LDS_BYTES, stream, a);
    const hipError_t le = hipPeekAtLastError(); if (le != hipSuccess) fprintf(stderr, "mega launch [%d,%d) failed: %s\n", lo, hi, hipGetErrorName(le)); };

  run(0, NPH);
}
```
